# Optimizing an MI355X kernel written in HIP

```python
import math
import jax
import jax.numpy as jnp
from jax import lax
import numpy as np

D_MODEL = 2048
BATCH = 4
SEQ = 4096
DEPTH = 4

GRID_W = 64
CTX_LEN = 256
N_MIXERS = 3
N_HYENA = (DEPTH + 2) // 3
N_HGRN = (DEPTH + 1) // 3
N_GLA = DEPTH // 3
N_MOD = 6
FFN_HIDDEN = 256 * (-(-8 * D_MODEL // (3 * 256)))
RMS_EPS = 1e-6
CHUNK = 64

HYENA_ORDER = 2
FILTER_BANDS = 16
FILTER_EMB = 1 + 2 * FILTER_BANDS
FILTER_HIDDEN = 64
HYENA_DECAY_TARGET = 1e-2
HYENA_SHORT_DECAY_PCT = 0.3
HYENA_LONG_DECAY_PCT = 1.5
HYENA_DECAY_MIN = math.log(HYENA_DECAY_TARGET) / HYENA_LONG_DECAY_PCT
HYENA_DECAY_MAX = math.log(HYENA_DECAY_TARGET) / HYENA_SHORT_DECAY_PCT

HGRN_EXPAND = 128
HGRN_HEADS = D_MODEL // HGRN_EXPAND
HGRN_IN_DIM = 5 * D_MODEL

GLA_HEADS = 4
GLA_KEY_DIM = D_MODEL // 2
GLA_VAL_DIM = D_MODEL
GLA_DK = GLA_KEY_DIM // GLA_HEADS
GLA_GATE_RANK = 16
GLA_GATE_NORM = 16.0
GLA_IN_DIM = 2 * GLA_KEY_DIM + 2 * GLA_VAL_DIM + 2 * GLA_GATE_RANK

kernel_name = "hybrid_hyena_hgrn2_gla_prefix_dit"


def rms_norm(x, g):
    xf = x.astype(jnp.float32)
    y = xf * lax.rsqrt(jnp.mean(xf * xf, axis=-1, keepdims=True) + RMS_EPS)
    return (y * g.astype(jnp.float32)).astype(x.dtype)


def head_rms_norm(o, g, n_heads):
    b, l, d = o.shape
    y = rms_norm(o.reshape(b, l, n_heads, d // n_heads), g.reshape(n_heads, d // n_heads))
    return y.reshape(b, l, d)


def modulate(h, shift, scale):
    return h * (1.0 + scale) + shift


def to_heads(a, n_heads):
    b, l, d = a.shape
    return a.reshape(b, l, n_heads, d // n_heads).transpose(0, 2, 1, 3)


def from_heads(a):
    b, h, l, d = a.shape
    return a.transpose(0, 2, 1, 3).reshape(b, l, h * d)


def swiglu(h, w_in, w_out):
    gate, up = jnp.split(h @ w_in, 2, axis=-1)
    return (jax.nn.silu(gate) * up) @ w_out


def short_conv3(u, w, n_rows):
    b, l, ch = u.shape
    r = u.reshape(b, n_rows, l // n_rows, ch)
    p = jnp.pad(r, ((0, 0), (0, 0), (1, 1), (0, 0)))
    y = w[0] * p[:, :, :-2] + w[1] * r + w[2] * p[:, :, 2:]
    return y.reshape(b, l, ch)


def hyena_filters(seq_len, fw1, fb1, ffreq, fw2, fb2, fwout):
    f32 = jnp.float32
    d = fwout.shape[-1] // (2 * HYENA_ORDER)
    pos = jnp.arange(seq_len, dtype=f32)
    t = pos / max(seq_len - 1, 1)
    bands = jnp.arange(1, FILTER_BANDS + 1, dtype=f32)
    ang = (2.0 * math.pi / seq_len) * pos[:, None] * bands[None, :]
    z = jnp.concatenate([t[:, None], jnp.cos(ang), -jnp.sin(ang)], axis=-1)
    hid = jnp.sin(ffreq[0].astype(f32) * (z @ fw1.astype(f32) + fb1.astype(f32)))
    hid = jnp.sin(ffreq[1].astype(f32) * (hid @ fw2.astype(f32) + fb2.astype(f32)))
    h = (hid @ fwout.astype(f32)).reshape(seq_len, 2, HYENA_ORDER, d)
    deltas = jnp.abs(jnp.linspace(HYENA_DECAY_MIN, HYENA_DECAY_MAX, d, dtype=f32))
    h = h * jnp.exp(-t[:, None] * deltas[None, :])[:, None, None, :]
    full = jnp.concatenate(
        [h[:, 0], jnp.zeros((1, HYENA_ORDER, d), f32), h[: seq_len - 1, 1][::-1]], axis=0)
    full = full / jnp.sum(jnp.abs(full), axis=0, keepdims=True)
    return jnp.fft.rfft(full, axis=0)


def fft_long_conv(u, h_freq, skip):
    l = u.shape[1]
    uf = u.astype(jnp.float32)
    y = jnp.fft.irfft(jnp.fft.rfft(uf, n=2 * l, axis=1) * h_freq[None], n=2 * l, axis=1)[:, :l]
    return (y + uf * skip.astype(jnp.float32)).astype(u.dtype)


def hyena_mix(h, n_rows, w_in, conv_w, fw1, fb1, ffreq, fw2, fb2, fwout, fskip, w_out):
    l = h.shape[1]
    v, x1, x2 = jnp.split(short_conv3(h @ w_in, conv_w, n_rows), 3, axis=-1)
    h_freq = hyena_filters(l, fw1, fb1, ffreq, fw2, fb2, fwout)
    z = x1 * fft_long_conv(v, h_freq[:, 0], fskip[0])
    z = x2 * fft_long_conv(z, h_freq[:, 1], fskip[1])
    return z @ w_out


def chunk_gla(q, k, v, g, s0):
    out_dtype = v.dtype
    q, k, v, g = (a.astype(jnp.float32) for a in (q, k, v, g))
    b, nh, l, _ = q.shape
    dv = v.shape[-1]
    n = l // CHUNK

    def to_chunks(a):
        return jnp.moveaxis(a.reshape(b, nh, n, CHUNK, a.shape[-1]), 2, 0)

    mask = jnp.tril(jnp.ones((CHUNK, CHUNK), bool))[:, :, None]

    def step(s, inp):
        qi, ki, vi, gi = inp
        bcum = jnp.cumsum(gi, axis=2)
        diff = bcum[:, :, :, None, :] - bcum[:, :, None, :, :]
        decay = jnp.exp(jnp.where(mask, diff, -jnp.inf))
        att = jnp.einsum('bhtd,bhsd,bhtsd->bhts', qi, ki, decay)
        o = (jnp.einsum('bhts,bhsv->bhtv', att, vi)
             + jnp.einsum('bhtd,bhdv->bhtv', qi * jnp.exp(bcum), s))
        btot = bcum[:, :, -1:, :]
        s_new = (jnp.exp(btot[:, :, 0, :])[..., None] * s
                 + jnp.einsum('bhsd,bhsv->bhdv', ki * jnp.exp(btot - bcum), vi))
        return s_new, o

    s_fin, oc = lax.scan(step, s0, tuple(to_chunks(a) for a in (q, k, v, g)))
    o = jnp.moveaxis(oc, 0, 2).reshape(b, nh, l, dv)
    return o.astype(out_dtype), s_fin


def prefix_scan(ctx_in, lat_in, reverse):
    if reverse:
        ctx_in = tuple(jnp.flip(a, axis=2) for a in ctx_in)
        lat_in = tuple(jnp.flip(a, axis=2) for a in lat_in)
    b, nh, _, dk = ctx_in[0].shape
    s0 = jnp.zeros((b, nh, dk, ctx_in[2].shape[-1]), jnp.float32)
    o_ctx, s_ctx = chunk_gla(*ctx_in, s0)
    o_lat, _ = chunk_gla(*lat_in, s_ctx)
    if reverse:
        o_ctx, o_lat = jnp.flip(o_ctx, axis=2), jnp.flip(o_lat, axis=2)
    return o_ctx, o_lat


def bidir_recurrence(ctx_dirs, lat_dirs):
    oc_f, ol_f = prefix_scan(ctx_dirs[0], lat_dirs[0], False)
    oc_b, ol_b = prefix_scan(ctx_dirs[1], lat_dirs[1], True)
    return from_heads(oc_f + oc_b), from_heads(ol_f + ol_b)


def hgrn2_inputs(h, w_in, lb):
    q, i_in, gate, f_fwd, f_bwd = jnp.split(h @ w_in, 5, axis=-1)
    q = to_heads(jax.nn.silu(q), HGRN_HEADS)
    v = to_heads(i_in, HGRN_HEADS)
    dirs = []
    for f_raw, lb_d in ((f_fwd, lb[0]), (f_bwd, lb[1])):
        log_f = jnp.logaddexp(jnp.log(lb_d),
                              jnp.log1p(-lb_d) + jax.nn.log_sigmoid(f_raw.astype(jnp.float32)))
        dirs.append((q, to_heads(-jnp.expm1(log_f), HGRN_HEADS), v, to_heads(log_f, HGRN_HEADS)))
    return dirs, gate


def hgrn2_mix(h_ctx, h_lat, layer_idx, w_in, lb_logits, onorm_g, w_out):
    lb_cum = jnp.cumsum(jax.nn.softmax(lb_logits.astype(jnp.float32), axis=1), axis=1)
    lb = lb_cum[:, layer_idx] - lb_cum[:, 0]
    ctx_dirs, g_ctx = hgrn2_inputs(h_ctx, w_in, lb)
    lat_dirs, g_lat = hgrn2_inputs(h_lat, w_in, lb)
    o_ctx, o_lat = bidir_recurrence(ctx_dirs, lat_dirs)
    y_ctx = (head_rms_norm(o_ctx, onorm_g, HGRN_HEADS) * jax.nn.silu(g_ctx)) @ w_out
    y_lat = (head_rms_norm(o_lat, onorm_g, HGRN_HEADS) * jax.nn.silu(g_lat)) @ w_out
    return y_ctx, y_lat


def gla_inputs(h, w_in, w_up, b_up):
    k0 = GLA_KEY_DIM
    v0 = 2 * GLA_KEY_DIM
    g0 = v0 + GLA_VAL_DIM
    a0 = g0 + GLA_VAL_DIM
    q, k, v, gate, a_f, a_b = jnp.split(h @ w_in, [k0, v0, g0, a0, a0 + GLA_GATE_RANK], axis=-1)
    q = to_heads(q * GLA_DK ** -0.5, GLA_HEADS)
    k = to_heads(k, GLA_HEADS)
    v = to_heads(v, GLA_HEADS)
    dirs = []
    for dr, a in enumerate((a_f, a_b)):
        log_a = jax.nn.log_sigmoid((a @ w_up[dr] + b_up[dr]).astype(jnp.float32)) / GLA_GATE_NORM
        dirs.append((q, k, v, to_heads(log_a, GLA_HEADS)))
    return dirs, gate


def gla_mix(h_ctx, h_lat, w_in, w_up, b_up, onorm_g, w_out):
    ctx_dirs, g_ctx = gla_inputs(h_ctx, w_in, w_up, b_up)
    lat_dirs, g_lat = gla_inputs(h_lat, w_in, w_up, b_up)
    o_ctx, o_lat = bidir_recurrence(ctx_dirs, lat_dirs)
    y_ctx = (head_rms_norm(o_ctx, onorm_g, GLA_HEADS) * jax.nn.silu(g_ctx)) @ w_out
    y_lat = (head_rms_norm(o_lat, onorm_g, GLA_HEADS) * jax.nn.silu(g_lat)) @ w_out
    return y_ctx, y_lat


def setup_inputs(seed: int = 0) -> dict:
    key = jax.random.key(seed)
    keys = iter(jax.random.split(key, 40))

    def nrm(shape, scale):
        return jax.random.normal(next(keys), shape, jnp.float32) * scale

    d = D_MODEL
    return {
        'x': nrm((BATCH, SEQ, d), 1.0),
        'c': nrm((BATCH, d), 1.0),
        'ctx': nrm((BATCH, CTX_LEN, d), 1.0),
        'c_ctx': nrm((d,), 1.0),
        'w_mod': nrm((DEPTH, d, N_MOD * d), 0.5 * d ** -0.5),
        'b_mod': nrm((DEPTH, N_MOD * d), 0.01),
        'norm1_g': 1.0 + nrm((DEPTH, d), 0.01),
        'norm2_g': 1.0 + nrm((DEPTH, d), 0.01),
        'w_ffn_in': nrm((DEPTH, d, 2 * FFN_HIDDEN), d ** -0.5),
        'w_ffn_out': nrm((DEPTH, FFN_HIDDEN, d), FFN_HIDDEN ** -0.5),
        'final_g': 1.0 + nrm((d,), 0.01),
        'hy_w_in': nrm((N_HYENA, d, 3 * d), d ** -0.5),
        'hy_conv_w': nrm((N_HYENA, 3, 3 * d), 3 ** -0.5),
        'hy_fw1': nrm((N_HYENA, FILTER_EMB, FILTER_HIDDEN), FILTER_EMB ** -0.5),
        'hy_fb1': nrm((N_HYENA, FILTER_HIDDEN), 0.1),
        'hy_ffreq': 1.0 + nrm((N_HYENA, 2, FILTER_HIDDEN), 0.1),
        'hy_fw2': nrm((N_HYENA, FILTER_HIDDEN, FILTER_HIDDEN), FILTER_HIDDEN ** -0.5),
        'hy_fb2': nrm((N_HYENA, FILTER_HIDDEN), 0.1),
        'hy_fwout': nrm((N_HYENA, FILTER_HIDDEN, 2 * HYENA_ORDER * d), FILTER_HIDDEN ** -0.5),
        'hy_fskip': nrm((N_HYENA, HYENA_ORDER, d), 0.1),
        'hy_w_out': nrm((N_HYENA, d, d), d ** -0.5),
        'hg_w_in': nrm((N_HGRN, d, HGRN_IN_DIM), d ** -0.5),
        'hg_lb_logits': nrm((2, DEPTH, d), 0.1),
        'hg_onorm_g': 1.0 + nrm((N_HGRN, d), 0.01),
        'hg_w_out': nrm((N_HGRN, d, d), d ** -0.5),
        'gla_w_in': nrm((N_GLA, d, GLA_IN_DIM), d ** -0.5),
        'gla_w_up': nrm((N_GLA, 2, GLA_GATE_RANK, GLA_KEY_DIM), GLA_GATE_RANK ** -0.5),
        'gla_b_up': nrm((N_GLA, 2, GLA_KEY_DIM), 0.1),
        'gla_onorm_g': 1.0 + nrm((N_GLA, GLA_VAL_DIM), 0.01),
        'gla_w_out': nrm((N_GLA, GLA_VAL_DIM, d), GLA_VAL_DIM ** -0.5),
    }


def reference(x, c, ctx, c_ctx, w_mod, b_mod, norm1_g, norm2_g, w_ffn_in, w_ffn_out, final_g,
              hy_w_in, hy_conv_w, hy_fw1, hy_fb1, hy_ffreq, hy_fw2, hy_fb2, hy_fwout, hy_fskip,
              hy_w_out, hg_w_in, hg_lb_logits, hg_onorm_g, hg_w_out,
              gla_w_in, gla_w_up, gla_b_up, gla_onorm_g, gla_w_out):
    rows = x.shape[1] // GRID_W
    sc = jax.nn.silu(c)[:, None, :]
    sc_ctx = jax.nn.silu(c_ctx)[None, None, :]
    for i in range(DEPTH):
        last = i == DEPTH - 1
        kind, j = i % N_MIXERS, i // N_MIXERS
        mod_lat = jnp.split(sc @ w_mod[i] + b_mod[i], N_MOD, axis=-1)
        mod_ctx = jnp.split(sc_ctx @ w_mod[i] + b_mod[i], N_MOD, axis=-1)
        h_lat = modulate(rms_norm(x, norm1_g[i]), mod_lat[0], mod_lat[1])
        need_ctx = (not last) or kind != 0
        h_ctx = modulate(rms_norm(ctx, norm1_g[i]), mod_ctx[0], mod_ctx[1]) if need_ctx else None
        if kind == 0:
            hy = (hy_w_in[j], hy_conv_w[j], hy_fw1[j], hy_fb1[j], hy_ffreq[j], hy_fw2[j],
                  hy_fb2[j], hy_fwout[j], hy_fskip[j], hy_w_out[j])
            y_lat = hyena_mix(h_lat, rows, *hy)
            y_ctx = hyena_mix(h_ctx, 1, *hy) if need_ctx else None
        elif kind == 1:
            y_ctx, y_lat = hgrn2_mix(h_ctx, h_lat, i, hg_w_in[j], hg_lb_logits,
                                     hg_onorm_g[j], hg_w_out[j])
        else:
            y_ctx, y_lat = gla_mix(h_ctx, h_lat, gla_w_in[j], gla_w_up[j], gla_b_up[j],
                                   gla_onorm_g[j], gla_w_out[j])
        x = x + mod_lat[2] * y_lat
        x = x + mod_lat[5] * swiglu(modulate(rms_norm(x, norm2_g[i]), mod_lat[3], mod_lat[4]),
                                    w_ffn_in[i], w_ffn_out[i])
        if not last:
            ctx = ctx + mod_ctx[2] * y_ctx
            ctx = ctx + mod_ctx[5] * swiglu(
                modulate(rms_norm(ctx, norm2_g[i]), mod_ctx[3], mod_ctx[4]),
                w_ffn_in[i], w_ffn_out[i])
    return rms_norm(x, final_g)
```

```cpp
#ifdef HOST_EMU
#include "emu.h"
#else
#include <hip/hip_runtime.h>
#include <cstdio>
#endif

#ifndef MK_PER_PHASE
#define MK_PER_PHASE 0
#endif

#ifndef DBG_ONLY
#define DBG_ONLY (-1)
#endif
#ifndef DBG_MASK
#define DBG_MASK 0
#endif
#define DBG(n) (DBG_ONLY < 0 || DBG_ONLY == (n) || ((DBG_MASK >> (n)) & 1))
#ifndef PROBE_MASK
#define PROBE_MASK 0
#endif
#define REPS(b) (((PROBE_MASK >> (b)) & 1) ? 2 : 1)
#define DI __device__ __forceinline__
typedef unsigned short bf16_t;
typedef short bf16x8 __attribute__((ext_vector_type(8)));
typedef float f32x4 __attribute__((ext_vector_type(4)));
typedef unsigned u32x4 __attribute__((ext_vector_type(4)));
typedef unsigned u32x2 __attribute__((ext_vector_type(2)));
typedef unsigned short u16x4 __attribute__((ext_vector_type(4)));

constexpr int D = 2048, NBATCH = 4, SEQ = 4096, T = NBATCH * SEQ, CL = 256, TC = NBATCH * CL, TT = T + TC;
constexpr int NMOD = 6, FF = 5632, DEPTH = 4, NTHREADS = 512;
constexpr float RMS_EPS = 1e-6f;
constexpr int HG_N = 5 * D;
constexpr int GLA_NV = 6144;
constexpr int GLA_N = 6176, GLA_NP = 6400;
constexpr int HY_N = 3 * D;

constexpr size_t al256(size_t x) { return (x + 255) & ~(size_t)255; }
constexpr size_t WS_CTL = 0, CTL_BYTES = 1u << 20;
constexpr size_t WS_MODV = WS_CTL + CTL_BYTES;
constexpr size_t WS_LB = WS_MODV + al256((size_t)DEPTH * 5 * NMOD * D * 4);
constexpr size_t WS_HID2L = WS_LB + al256(2 * D * 4);
constexpr size_t WS_HID2C = WS_HID2L + (size_t)2 * SEQ * 64 * 4;
constexpr size_t WS_WHYIN = WS_HID2C + (size_t)2 * CL * 64 * 4;
constexpr size_t WS_WHYOUT = WS_WHYIN + (size_t)2 * HY_N * D * 2;
constexpr size_t WS_WHGIN = WS_WHYOUT + (size_t)2 * D * D * 2;
constexpr size_t WS_WHGOUT = WS_WHGIN + (size_t)HG_N * D * 2;
constexpr size_t WS_WGLIN = WS_WHGOUT + (size_t)D * D * 2;
constexpr size_t WS_WGLOUT = WS_WGLIN + (size_t)GLA_NP * D * 2;
constexpr size_t WS_WFIN = WS_WGLOUT + (size_t)D * D * 2;
constexpr size_t WS_WFOUT = WS_WFIN + (size_t)DEPTH * 2 * FF * D * 2;
constexpr size_t WS_X = WS_WFOUT + (size_t)DEPTH * D * FF * 2;
constexpr size_t WS_U = WS_X + (size_t)TT * D * 4;
constexpr size_t WS_O2 = WS_U + (size_t)TT * HG_N * 2;
constexpr size_t WS_HTS = WS_O2 + (size_t)D * TT * 2;
constexpr size_t WS_GA = WS_O2 + (size_t)2 * TT * D * 4;
constexpr size_t WS_HN = WS_GA + (size_t)TT * 32 * 4;
constexpr size_t WS_TAIL = WS_HN + (size_t)TT * D * 2;
constexpr size_t WS_HYS = WS_TAIL;
constexpr size_t HYS_PER_BLOCK = (size_t)32 * 512 * 4;
constexpr size_t WS_PQT = WS_HN;
constexpr size_t WS_PKT = WS_PQT + (size_t)2 * TT * D * 2;
constexpr size_t WS_PVT = WS_PKT + (size_t)2 * TT * D * 2;
constexpr size_t WS_PEM = WS_PVT + (size_t)TT * D * 2;
constexpr size_t WS_END = WS_PEM + (size_t)2 * 4 * 16 * 68 * 2 * 128 * 4;
static_assert(WS_HYS + 256 * HYS_PER_BLOCK <= WS_END, "hyena scratch");
static_assert(WS_HTS + (size_t)256 * 8 * 4 * SEQ * 4 <= WS_GA, "hyena filter scratch");
static_assert(WS_END <= (size_t)1610612736, "workspace budget (4 x largest input)");

constexpr int LDS_BYTES = 163840;
constexpr int LDS_BAR_OFF = LDS_BYTES - 16;

#ifdef HOST_EMU
static inline unsigned f_as_u(float f) { unsigned u; memcpy(&u, &f, 4); return u; }
static inline float u_as_f(unsigned u) { float f; memcpy(&f, &u, 4); return f; }
static inline float sin_rev(float x) { return (float)sin(6.283185307179586 * (double)x); }
static inline float cos_rev(float x) { return (float)cos(6.283185307179586 * (double)x); }
static inline f32x4 mma16(bf16x8 x, bf16x8 y, f32x4 c) { return emu_mfma_16x16x32(x, y, c); }
static inline float shfl_xor_f(float v, int m) { return emu_shfl_xor(v, m); }
static inline float fast_rcp(float x) { return 1.0f / x; }
static inline float pin_f(float x) { return x; }
static inline float lane_xor1(float v) { return emu_shfl_xor(v, 1); }
static inline float lane_prev(float v) { const float r = emu_shfl(v, (emu::S.cur & 63) - 1); return (emu::S.cur & 63) == 0 ? 0.f : r; }
static inline float lane_next(float v) { const float r = emu_shfl(v, (emu::S.cur & 63) + 1); return (emu::S.cur & 63) == 63 ? 0.f : r; }
#define PIN_ACC(a) do { } while (0)
#define PIN4(a, b, c, d) do { } while (0)
#define PIN12(a) do { } while (0)
#define MEM_FENCE() do { } while (0)
static inline void lds_barrier() { emu::block_barrier(); }
static inline float fexp2(float x) { return exp2f(x); }
static inline float flog2(float x) { return log2f(x); }
static inline int tidx() { return (int)threadIdx.x; }
static inline void atomic_add_f32(float* p, float v) { *p += v; }
#else
DI unsigned f_as_u(float f) { return __float_as_uint(f); }
DI float u_as_f(unsigned u) { return __uint_as_float(u); }
DI float sin_rev(float x) { return __builtin_amdgcn_sinf(x); }
DI float cos_rev(float x) { return __builtin_amdgcn_cosf(x); }
DI f32x4 mma16(bf16x8 x, bf16x8 y, f32x4 c) { return __builtin_amdgcn_mfma_f32_16x16x32_bf16(x, y, c, 0, 0, 0); }
DI float shfl_xor_f(float v, int m) { return __shfl_xor(v, m); }
DI float fast_rcp(float x) { return __builtin_amdgcn_rcpf(x); }
DI float pin_f(float x) { asm volatile("" : "+v"(x)); return x; }
#define PIN_ACC(a) asm volatile("" : "+v"(a))
#define PIN4(a, b, c, d) asm volatile("" : "+v"(a), "+v"(b), "+v"(c), "+v"(d))
#define PIN12(a) asm volatile("" : "+v"(a[0]), "+v"(a[1]), "+v"(a[2]), "+v"(a[3]), "+v"(a[4]), "+v"(a[5]), "+v"(a[6]), "+v"(a[7]), "+v"(a[8]), "+v"(a[9]), "+v"(a[10]), "+v"(a[11]))
#define MEM_FENCE() asm volatile("" ::: "memory")
DI void lds_barrier() { asm volatile("s_waitcnt lgkmcnt(0)\n\ts_barrier" ::: "memory"); }
DI float lane_xor1(float v) { return __builtin_bit_cast(float, __builtin_amdgcn_update_dpp(0, __builtin_bit_cast(int, v), 0xB1, 0xf, 0xf, true)); }
DI float lane_prev(float v) { return __builtin_bit_cast(float, __builtin_amdgcn_update_dpp(0, __builtin_bit_cast(int, v), 0x138, 0xf, 0xf, true)); }
DI float lane_next(float v) { return __builtin_bit_cast(float, __builtin_amdgcn_update_dpp(0, __builtin_bit_cast(int, v), 0x130, 0xf, 0xf, true)); }
DI float fexp2(float x) { return __builtin_amdgcn_exp2f(x); }
DI float flog2(float x) { return __builtin_amdgcn_logf(x); }
DI void atomic_add_f32(float* p, float v) { (void)__hip_atomic_fetch_add(p, v, __ATOMIC_RELAXED, __HIP_MEMORY_SCOPE_AGENT); }
DI int tidx() { int t = (int)threadIdx.x; asm volatile("" : "+v"(t)); return t; }
#endif
#ifdef HOST_EMU
DI bf16_t f2bf(float f) { unsigned u = f_as_u(f); u += 0x7fffu + ((u >> 16) & 1u); return (bf16_t)(u >> 16); }
DI unsigned pack_bf2(float lo, float hi) { return (unsigned)f2bf(lo) | ((unsigned)f2bf(hi) << 16); }
#else
typedef float f32x2_t __attribute__((ext_vector_type(2)));
typedef __bf16 bf16x2_t __attribute__((ext_vector_type(2)));
DI unsigned pack_bf2(float lo, float hi) { const bf16x2_t r = __builtin_convertvector((f32x2_t){lo, hi}, bf16x2_t); return __builtin_bit_cast(unsigned, r); }
DI bf16_t f2bf(float f) { return (bf16_t)(pack_bf2(f, f) & 0xffffu); }
#endif
DI float bf2f(bf16_t b) { return u_as_f(((unsigned)b) << 16); }
DI float silu_f(float x) { return x / (1.0f + expf(-x)); }
DI float silu_fast(float x) { return x * fast_rcp(1.0f + fexp2(-1.4426950408889634f * x)); }
DI float wave_sum(float v) { v += shfl_xor_f(v, 32); v += shfl_xor_f(v, 16); v += shfl_xor_f(v, 8); v += shfl_xor_f(v, 4); v += shfl_xor_f(v, 2); v += shfl_xor_f(v, 1); return v; }
DI int mod_index(int row) { return row < T ? row / SEQ : NBATCH; }

#ifndef HOST_EMU
#define XB_TMO      128
#define XB_XCNT(j)  (256  + 64 * (j))
#define XB_XSUB(j)  (1280 + 64 * (j))
#define XB_XGEN(j)  (2304 + 64 * (j))
#define XB_TOP      3328
#define XB_TOPGEN   3392
#define XCD_BAR_WORDS 3456
#define XB_SPIN_CAP (1u << 22)
#define LAS __attribute__((address_space(3)))

__device__ __forceinline__ unsigned xb_ld(unsigned* p)              { return __hip_atomic_load(p, __ATOMIC_RELAXED, __HIP_MEMORY_SCOPE_AGENT); }
__device__ __forceinline__ unsigned xb_add(unsigned* p, unsigned v) { return __hip_atomic_fetch_add(p, v, __ATOMIC_RELAXED, __HIP_MEMORY_SCOPE_AGENT); }
__device__ __forceinline__ unsigned xb_xcc_id() { return (unsigned)__builtin_amdgcn_s_getreg((3 << 11) | 20) & 0xFu; }
#define XB_SPIN(cond, bar) do { unsigned _sp = 0; while (cond) { __builtin_amdgcn_s_sleep(1); \
    if ((++_sp & 255u) == 0u) { if (xb_ld(&(bar)[XB_TMO])) break; if (_sp > XB_SPIN_CAP) { atomicAdd(&(bar)[XB_TMO], 1u); break; } } } } while (0)

struct XcdBarrier { unsigned* bar; unsigned x; volatile LAS unsigned* st; };

__device__ __forceinline__ XcdBarrier xcd_barrier_post(unsigned* bar, volatile LAS unsigned* st) {
    XcdBarrier b; b.bar = bar; b.x = xb_xcc_id(); b.st = st;
    if (threadIdx.x == 0) (void)xb_add(&bar[XB_XCNT(b.x)], 1u);
    return b;
}
__device__ __forceinline__ void xcd_barrier_complete(unsigned* bar, unsigned x, unsigned& nloc, unsigned& nx) {
    const unsigned G = gridDim.x * gridDim.y * gridDim.z;
    unsigned sum, cnt, mine, sp = 0u;
    for (;;) {
        sum = 0u; cnt = 0u; mine = 0u;
#pragma unroll
        for (unsigned j = 0; j < 16; ++j) { const unsigned c = xb_ld(&bar[XB_XCNT(j)]); sum += c; cnt += (c > 0u) ? 1u : 0u; mine = (j == x) ? c : mine; }
        if (sum == G) break;
        __builtin_amdgcn_s_sleep(1);
        if ((++sp & 255u) == 0u) { if (xb_ld(&bar[XB_TMO])) break; if (sp > XB_SPIN_CAP) { atomicAdd(&bar[XB_TMO], 1u); break; } }
    }
    nloc = mine > 0u ? mine : 1u; nx = cnt > 0u ? cnt : 1u;
}
__device__ __forceinline__ void xcd_barrier(const XcdBarrier& b) {
    asm volatile("s_waitcnt vmcnt(0)" ::: "memory");
    __syncthreads();
    if (threadIdx.x == 0) {
        unsigned* bar = b.bar;
        __builtin_amdgcn_s_waitcnt(0);
        unsigned nloc = b.st[0], nx = b.st[1];
        if (nloc == 0u) { xcd_barrier_complete(bar, b.x, nloc, nx); b.st[0] = nloc; b.st[1] = nx; }
        const unsigned old = xb_add(&bar[XB_XSUB(b.x)], 1u);
        const unsigned gen = old / nloc;
        if (old + 1u == (gen + 1u) * nloc) {
            __builtin_amdgcn_fence(__ATOMIC_RELEASE, "agent");
            asm volatile("s_waitcnt vmcnt(0)" ::: "memory");
            const unsigned og = xb_add(&bar[XB_TOP], 1u);
            const unsigned tg = og / nx;
            if (og + 1u == (tg + 1u) * nx) xb_add(&bar[XB_TOPGEN], 1u);
            else XB_SPIN(xb_ld(&bar[XB_TOPGEN]) == tg, bar);
            __builtin_amdgcn_fence(__ATOMIC_ACQUIRE, "agent");
            xb_add(&bar[XB_XGEN(b.x)], 1u);
            asm volatile("s_waitcnt vmcnt(0)" ::: "memory");
        } else {
            XB_SPIN(xb_ld(&bar[XB_XGEN(b.x)]) == gen, bar);
            __builtin_amdgcn_fence(__ATOMIC_ACQUIRE, "agent");
            asm volatile("s_waitcnt vmcnt(0)" ::: "memory");
        }
    }
    __syncthreads();
}
#endif

namespace pg8 {
constexpr int BM = 256, BK = 64, HALF = 128, HTB = HALF * BK * 2, STAGE_BYTES = 8 * HTB, NXCD = 8, WGM = 4;
struct Unit { int pm, pn, pk; };
struct Gemm { const bf16_t* A; const bf16_t* Bt; int M, N, K, ld; };
struct StaticOrder {
    int nM, nN, nwg, G, c;
    __host__ __device__ void init(int M, int N, int G_, int c_) { nM = M / BM; nN = N / BM; nwg = nM * nN; G = G_; c = c_; }
    __host__ __device__ bool next(int i, Unit& u) const {
        const long L = (long)i * G + c; if (L >= nwg) return false;
        int wgid = (int)L; { const int q = nwg / NXCD, r = nwg % NXCD, xcd = wgid % NXCD, off = wgid / NXCD; wgid = (xcd < r ? xcd * (q + 1) : r * (q + 1) + (xcd - r) * q) + off; }
        const int nig = WGM * nN, gid = wgid / nig, fm = gid * WGM, gsz = (nM - fm) < WGM ? (nM - fm) : WGM;
        u.pm = fm + ((wgid % nig) % gsz); u.pn = (wgid % nig) / gsz; u.pk = 0; return true;
    }
    __device__ __forceinline__ void a_ready(const Unit&) const {}
    __device__ __forceinline__ void done(const Unit&) const {}
};
struct SplitKOrder {
    int nM, nN, nK, nwg, G, c;
    __host__ __device__ void init(int M, int N, int nK_, int G_, int c_) { nM = M / BM; nN = N / BM; nK = nK_; nwg = nM * nN * nK; G = G_; c = c_; }
    __host__ __device__ bool next(int i, Unit& u) const { const long L = (long)i * G + c; if (L >= nwg) return false; const int l = (int)L; u.pn = l % nN; u.pm = (l / nN) % nM; u.pk = l / (nN * nM); return true; }
    __device__ __forceinline__ void a_ready(const Unit&) const {}
    __device__ __forceinline__ void done(const Unit&) const {}
};
#ifndef HOST_EMU
#define PG8_LAS __attribute__((address_space(3)))
__host__ __device__ __forceinline__ int lds_byte(int r, int c) { const int st = (r >> 4) * 2 + (c >> 5), rr = r & 15, cc = c & 31, ob = rr * 64 + cc * 2; return st * 1024 + (ob ^ (((ob >> 9) & 1) << 5)); }
__host__ __device__ __forceinline__ void stage_rc(int b, int& R, int& C) { const int st = b / 1024, sb = b % 1024, swz = sb ^ (((sb >> 9) & 1) << 5); R = (st >> 1) * 16 + swz / 64; C = (st & 1) * 32 + (swz % 64) / 2; }
__host__ __device__ __forceinline__ int perm32(int rho) { const int n = rho >> 4, i = rho & 15; return 8 * (i >> 2) + 4 * n + (i & 3); }

template <class Epi, class Sched>
__device__ __forceinline__ void gemm_phase(PG8_LAS unsigned char* lds, const Gemm g, const Sched& S, const Epi& E) {
    const int tid = tidx(), wid = __builtin_amdgcn_readfirstlane(tid >> 6), lane = tid & 63, wr = wid >> 2, wc = wid & 3, fr = lane & 15, fq = lane >> 4;
    const int K = g.ld, nt = g.K / BK;
    const size_t kpart = (size_t)g.K * 2;
    unsigned voffA[2], voffB[2];
#pragma unroll
    for (int i = 0; i < 2; ++i) { int R, C; stage_rc(tid * 16 + i * 8192, R, C); const int Rb = Epi::PERM ? ((R & ~31) + perm32(R & 31)) : R;
        voffA[i] = (unsigned)(R * K + C) * 2u; voffB[i] = (unsigned)(Rb * K + C) * 2u; }
    const size_t kstep = (size_t)(BK * 2);
    const size_t hstep = (size_t)HALF * K * 2;
    const size_t tstep = 2 * hstep;
    const unsigned ldsw = (unsigned)wid * 1024u;
    const int aoff = lds_byte(wr * 64 + fr, fq * 8), boff = lds_byte(wc * 32 + fr, fq * 8);
#define PG8_SA(b, h) (((b) * 2 + (h)) * HTB)
#define PG8_SB(b, h) ((4 + (b) * 2 + (h)) * HTB)
#define PG8_STAGE(bufoff, gbase, voff) do { _Pragma("unroll") for (int _i = 0; _i < 2; ++_i) \
        __builtin_amdgcn_global_load_lds((const unsigned*)((const char*)(gbase) + (voff)[_i]), (PG8_LAS unsigned*)(lds + (bufoff) + ldsw + _i * 8192), 16, 0, 0); } while (0)
#define PG8_LDA(dst, b, h) do { _Pragma("unroll") for (int m = 0; m < 4; ++m) _Pragma("unroll") for (int k = 0; k < 2; ++k) dst[m][k] = *(const PG8_LAS bf16x8*)(lds + PG8_SA(b, h) + aoff + m * 2048 + k * 1024); } while (0)
#define PG8_LDB(dst, b, h) do { _Pragma("unroll") for (int n = 0; n < 2; ++n) _Pragma("unroll") for (int k = 0; k < 2; ++k) dst[n][k] = *(const PG8_LAS bf16x8*)(lds + PG8_SB(b, h) + boff + n * 2048 + k * 1024); } while (0)
#define PG8_MMA(ai, bj, At, Bt) do { __builtin_amdgcn_s_setprio(1); _Pragma("unroll") for (int m = 0; m < 4; ++m) _Pragma("unroll") for (int n = 0; n < 2; ++n) _Pragma("unroll") for (int k = 0; k < 2; ++k) \
        acc[ai][bj][m][n] = __builtin_amdgcn_mfma_f32_16x16x32_bf16(Bt[n][k], At[m][k], acc[ai][bj][m][n], 0, 0, 0); __builtin_amdgcn_s_setprio(0); } while (0)
#define PG8_WAIT_V(n) asm volatile("s_waitcnt vmcnt(" #n ")" ::: "memory")
#define PG8_WAIT_L(n) asm volatile("s_waitcnt lgkmcnt(" #n ")" ::: "memory")
#define PG8_BAR __builtin_amdgcn_s_barrier()
#define PG8_SCHED __builtin_amdgcn_sched_barrier(0)
    Unit cur, nxt; int ui = 0;
    if (!S.next(0, cur)) return;
    f32x4 acc[2][2][4][2];
#pragma unroll
    for (int a = 0; a < 2; ++a)
#pragma unroll
        for (int b = 0; b < 2; ++b)
#pragma unroll
            for (int m = 0; m < 4; ++m)
#pragma unroll
                for (int n = 0; n < 2; ++n) acc[a][b][m][n] = (f32x4){0.f, 0.f, 0.f, 0.f};
    bf16x8 At[4][2], B0[2][2], B1[2][2];
    const char* cA = (const char*)g.A + (size_t)cur.pm * tstep + (size_t)cur.pk * kpart; const char* cB = (const char*)g.Bt + (size_t)cur.pn * tstep + (size_t)cur.pk * kpart;
    S.a_ready(cur);
    PG8_STAGE(PG8_SB(0, 0), cB, voffB); PG8_STAGE(PG8_SA(0, 0), cA, voffA); PG8_STAGE(PG8_SB(0, 1), cB + hstep, voffB); PG8_STAGE(PG8_SA(0, 1), cA + hstep, voffA);
    if (wr == 1) PG8_BAR;
    PG8_WAIT_V(4); PG8_BAR;
    PG8_STAGE(PG8_SB(1, 0), cB + kstep, voffB); PG8_STAGE(PG8_SA(1, 0), cA + kstep, voffA); PG8_STAGE(PG8_SB(1, 1), cB + hstep + kstep, voffB);
    PG8_WAIT_V(6); PG8_BAR;
    for (;;) {
        const bool has_next = S.next(ui + 1, nxt);
        const char* nA = has_next ? (const char*)g.A + (size_t)nxt.pm * tstep + (size_t)nxt.pk * kpart : cA; const char* nB = has_next ? (const char*)g.Bt + (size_t)nxt.pn * tstep + (size_t)nxt.pk * kpart : cB;
        for (int t = 0; t < nt; t += 2) {
            const bool last = (t == nt - 2);
            const char* a1 = cA + (size_t)(t + 1) * kstep;
            const char* a2 = last ? nA : cA + (size_t)(t + 2) * kstep; const char* b2 = last ? nB : cB + (size_t)(t + 2) * kstep;
            const char* a3 = a2 + kstep; const char* b3 = b2 + kstep;
            if (last && has_next) S.a_ready(nxt);
            PG8_LDB(B0, 0, 0); PG8_SCHED; PG8_LDA(At, 0, 0); PG8_STAGE(PG8_SA(1, 1), a1 + hstep, voffA);
            PG8_WAIT_L(8); PG8_BAR; PG8_WAIT_L(0); PG8_MMA(0, 0, At, B0); PG8_BAR; PG8_SCHED;
            PG8_LDB(B1, 0, 1); PG8_STAGE(PG8_SB(0, 0), b2, voffB);
            PG8_BAR; PG8_WAIT_L(0); PG8_MMA(0, 1, At, B1); PG8_BAR;
            PG8_LDA(At, 0, 1); PG8_STAGE(PG8_SA(0, 0), a2, voffA);
            PG8_BAR; PG8_WAIT_L(0); PG8_MMA(1, 0, At, B0); PG8_BAR; PG8_SCHED;
            PG8_STAGE(PG8_SB(0, 1), b2 + hstep, voffB);
            PG8_WAIT_V(6); PG8_BAR; PG8_MMA(1, 1, At, B1); PG8_BAR;
            PG8_LDB(B0, 1, 0); PG8_SCHED; PG8_LDA(At, 1, 0); PG8_STAGE(PG8_SA(0, 1), a2 + hstep, voffA);
            PG8_WAIT_L(8); PG8_BAR; PG8_WAIT_L(0); PG8_MMA(0, 0, At, B0); PG8_BAR; PG8_SCHED;
            PG8_LDB(B1, 1, 1); PG8_STAGE(PG8_SB(1, 0), b3, voffB);
            PG8_BAR; PG8_WAIT_L(0); PG8_MMA(0, 1, At, B1); PG8_BAR;
            PG8_LDA(At, 1, 1); PG8_STAGE(PG8_SA(1, 0), a3, voffA);
            PG8_BAR; PG8_WAIT_L(0); PG8_MMA(1, 0, At, B0); PG8_BAR; PG8_SCHED;
            PG8_STAGE(PG8_SB(1, 1), b3 + hstep, voffB);
            PG8_WAIT_V(6); PG8_BAR; PG8_MMA(1, 1, At, B1); PG8_BAR;
        }
        E(acc, cur, wr, wc, fr, fq); S.done(cur);
        if (!has_next) break;
#pragma unroll
        for (int a = 0; a < 2; ++a)
#pragma unroll
            for (int b = 0; b < 2; ++b)
#pragma unroll
                for (int m = 0; m < 4; ++m)
#pragma unroll
                    for (int n = 0; n < 2; ++n) acc[a][b][m][n] = (f32x4){0.f, 0.f, 0.f, 0.f};
        cur = nxt; cA = nA; cB = nB; ++ui;
    }
    PG8_WAIT_V(0);
    if (wr == 0) PG8_BAR;
    PG8_BAR;
#undef PG8_SA
#undef PG8_SB
#undef PG8_STAGE
#undef PG8_LDA
#undef PG8_LDB
#undef PG8_MMA
#undef PG8_WAIT_V
#undef PG8_WAIT_L
#undef PG8_BAR
#undef PG8_SCHED
}
#else
template <class Epi, class Sched>
static inline void gemm_phase(unsigned char*, const Gemm g, const Sched& S, const Epi& E) {
    const int tid = threadIdx.x, wid = tid >> 6, lane = tid & 63, wr = wid >> 2, wc = wid & 3, fr = lane & 15, fq = lane >> 4;
    Unit u;
    for (int ui = 0; S.next(ui, u); ++ui) {
        f32x4 acc[2][2][4][2];
        for (int ai = 0; ai < 2; ++ai) for (int bj = 0; bj < 2; ++bj) for (int m = 0; m < 4; ++m) for (int n = 0; n < 2; ++n) for (int j = 0; j < 4; ++j) {
            const int r = 256 * u.pm + 128 * ai + 64 * wr + 16 * m + fr;
            const int c = Epi::PERM ? 256 * u.pn + 128 * bj + 32 * wc + 8 * fq + 4 * n + j : 256 * u.pn + 128 * bj + 32 * wc + 16 * n + 4 * fq + j;
            double s = 0; for (int k = u.pk * g.K; k < (u.pk + 1) * g.K; ++k) s += (double)bf2f(g.A[(size_t)r * g.ld + k]) * (double)bf2f(g.Bt[(size_t)c * g.ld + k]);
            acc[ai][bj][m][n][j] = (float)s; }
        E(acc, u, wr, wc, fr, fq);
    }
}
#endif
}

struct EpiStoreBf16 {
    static constexpr bool PERM = true;
    bf16_t* O; int ldc;
    DI void operator()(const f32x4 (&acc)[2][2][4][2], const pg8::Unit& u, int wr, int wc, int fr, int fq) const {
        const int row0 = u.pm * 256 + wr * 64 + fr, col0 = u.pn * 256 + wc * 32 + 8 * fq;
#pragma unroll
        for (int ai = 0; ai < 2; ++ai)
#pragma unroll
            for (int m = 0; m < 4; ++m) { bf16_t* rowp = O + (size_t)(row0 + ai * 128 + m * 16) * ldc + col0;
#pragma unroll
                for (int bj = 0; bj < 2; ++bj) { const f32x4 v0 = acc[ai][bj][m][0], v1 = acc[ai][bj][m][1];
                    u32x4 w; w.x = pack_bf2(v0[0], v0[1]); w.y = pack_bf2(v0[2], v0[3]); w.z = pack_bf2(v1[0], v1[1]); w.w = pack_bf2(v1[2], v1[3]);
                    *(u32x4*)(rowp + bj * 128) = w; } }
    }
};
template <bool IN_F32>
struct EpiResid {
    static constexpr bool PERM = true;
    const void* Xin; bf16_t* Xout; const float* gate;
    DI void operator()(const f32x4 (&acc)[2][2][4][2], const pg8::Unit& u, int wr, int wc, int fr, int fq) const {
        const int row0 = u.pm * 256 + wr * 64 + fr, col0 = u.pn * 256 + wc * 32 + 8 * fq;
        const float* gp = gate + (size_t)mod_index(u.pm * 256) * (NMOD * D) + col0;
        f32x4 gv[2][2];
#pragma unroll
        for (int bj = 0; bj < 2; ++bj)
#pragma unroll
            for (int n = 0; n < 2; ++n) gv[bj][n] = *(const f32x4*)(gp + bj * 128 + n * 4);
        if constexpr (IN_F32) {
            const float* Xf = (const float*)Xin;
#pragma unroll
            for (int am = 0; am < 4; ++am) { const int ai = am >> 1, mh = (am & 1) * 2; f32x4 xv[2][2][2];
#pragma unroll
                for (int m = 0; m < 2; ++m) { const size_t off = (size_t)(row0 + ai * 128 + (mh + m) * 16) * D + col0;
#pragma unroll
                    for (int bj = 0; bj < 2; ++bj)
#pragma unroll
                        for (int n = 0; n < 2; ++n) xv[m][bj][n] = *(const f32x4*)(Xf + off + bj * 128 + n * 4); }
                MEM_FENCE();
#pragma unroll
                for (int m = 0; m < 2; ++m) { const size_t off = (size_t)(row0 + ai * 128 + (mh + m) * 16) * D + col0;
#pragma unroll
                    for (int bj = 0; bj < 2; ++bj) { const f32x4 v0 = xv[m][bj][0] + gv[bj][0] * acc[ai][bj][mh + m][0], v1 = xv[m][bj][1] + gv[bj][1] * acc[ai][bj][mh + m][1];
                        u32x4 w; w.x = pack_bf2(v0[0], v0[1]); w.y = pack_bf2(v0[2], v0[3]); w.z = pack_bf2(v1[0], v1[1]); w.w = pack_bf2(v1[2], v1[3]);
                        *(u32x4*)(Xout + off + bj * 128) = w; } }
                MEM_FENCE(); }
        } else {
            const bf16_t* Xb = (const bf16_t*)Xin;
#pragma unroll
            for (int ai = 0; ai < 2; ++ai) { u32x4 xv[4][2];
#pragma unroll
                for (int m = 0; m < 4; ++m) { const size_t off = (size_t)(row0 + ai * 128 + m * 16) * D + col0;
#pragma unroll
                    for (int bj = 0; bj < 2; ++bj) xv[m][bj] = *(const u32x4*)(Xb + off + bj * 128); }
                MEM_FENCE();
#pragma unroll
                for (int m = 0; m < 4; ++m) { const size_t off = (size_t)(row0 + ai * 128 + m * 16) * D + col0;
#pragma unroll
                    for (int bj = 0; bj < 2; ++bj) { const u32x4 x = xv[m][bj];
                        const f32x4 x0 = {u_as_f(x.x << 16), u_as_f(x.x & 0xffff0000u), u_as_f(x.y << 16), u_as_f(x.y & 0xffff0000u)};
                        const f32x4 x1 = {u_as_f(x.z << 16), u_as_f(x.z & 0xffff0000u), u_as_f(x.w << 16), u_as_f(x.w & 0xffff0000u)};
                        const f32x4 v0 = x0 + gv[bj][0] * acc[ai][bj][m][0], v1 = x1 + gv[bj][1] * acc[ai][bj][m][1];
                        u32x4 w; w.x = pack_bf2(v0[0], v0[1]); w.y = pack_bf2(v0[2], v0[3]); w.z = pack_bf2(v1[0], v1[1]); w.w = pack_bf2(v1[2], v1[3]);
                        *(u32x4*)(Xout + off + bj * 128) = w; } }
                MEM_FENCE(); }
        }
    }
};
struct EpiPartial {
    static constexpr bool PERM = false;
    float* P;
    DI void operator()(const f32x4 (&acc)[2][2][4][2], const pg8::Unit& u, int wr, int wc, int fr, int fq) const {
        const int row0 = u.pm * 256 + wr * 64 + fr, col0 = u.pn * 256 + wc * 32 + 4 * fq;
        float* base = P + (size_t)u.pk * TC * D;
#pragma unroll
        for (int ai = 0; ai < 2; ++ai)
#pragma unroll
            for (int m = 0; m < 4; ++m) { float* xp = base + (size_t)(row0 + ai * 128 + m * 16) * D + col0;
#pragma unroll
                for (int bj = 0; bj < 2; ++bj)
#pragma unroll
                    for (int n = 0; n < 2; ++n) *(f32x4*)(xp + bj * 128 + n * 16) = acc[ai][bj][m][n]; }
    }
};
struct EpiSwiGLU {
    static constexpr bool PERM = true;
    bf16_t* O;
    DI void operator()(const f32x4 (&acc)[2][2][4][2], const pg8::Unit& u, int wr, int wc, int fr, int fq) const {
        const int row0 = u.pm * 256 + wr * 64 + fr, col0 = u.pn * 128 + wc * 32 + 8 * fq;
#pragma unroll
        for (int ai = 0; ai < 2; ++ai)
#pragma unroll
            for (int m = 0; m < 4; ++m) { bf16_t* rowp = O + (size_t)(row0 + ai * 128 + m * 16) * FF + col0;
                float r[8];
#pragma unroll
                for (int n = 0; n < 2; ++n)
#pragma unroll
                    for (int j = 0; j < 4; ++j) { const float gt = acc[ai][0][m][n][j], up = acc[ai][1][m][n][j]; r[n * 4 + j] = silu_fast(gt) * up; }
                u32x4 w; w.x = pack_bf2(r[0], r[1]); w.y = pack_bf2(r[2], r[3]); w.z = pack_bf2(r[4], r[5]); w.w = pack_bf2(r[6], r[7]);
                *(u32x4*)rowp = w; }
    }
};
struct EpiHgIn {
    static constexpr bool PERM = true;
    bf16_t* O; const float* lb;
    DI void operator()(const f32x4 (&acc)[2][2][4][2], const pg8::Unit& u, int wr, int wc, int fr, int fq) const {
        const int row0 = u.pm * 256 + wr * 64 + fr, col0 = u.pn * 256 + wc * 32 + 8 * fq;
        const int seg = (u.pn * 256) / D;
#pragma unroll
        for (int bj = 0; bj < 2; ++bj) {
            float lbv[8];
            if (seg >= 3) {
#pragma unroll
                for (int j = 0; j < 8; ++j) lbv[j] = lb[col0 + bj * 128 + j - 3 * D];
            }
#pragma unroll
            for (int ai = 0; ai < 2; ++ai)
#pragma unroll
                for (int m = 0; m < 4; ++m) { float r[8];
#pragma unroll
                    for (int n = 0; n < 2; ++n)
#pragma unroll
                        for (int j = 0; j < 4; ++j) { const float x = acc[ai][bj][m][n][j]; float y;
                            if (seg == 1) y = x;
                            else if (seg == 0 || seg == 2) y = silu_fast(x);
                            else { const float l = lbv[n * 4 + j], sg = fast_rcp(1.0f + fexp2(-1.4426950408889634f * x)); y = 0.6931471805599453f * flog2(l + (1.0f - l) * sg); }
                            r[n * 4 + j] = y; }
                    u32x4 w; w.x = pack_bf2(r[0], r[1]); w.y = pack_bf2(r[2], r[3]); w.z = pack_bf2(r[4], r[5]); w.w = pack_bf2(r[6], r[7]);
                    *(u32x4*)(O + (size_t)(row0 + ai * 128 + m * 16) * HG_N + col0 + bj * 128) = w; }
        }
    }
};
struct EpiGlaIn {
    static constexpr bool PERM = true;
    bf16_t* O; float* GA;
    DI void operator()(const f32x4 (&acc)[2][2][4][2], const pg8::Unit& u, int wr, int wc, int fr, int fq) const {
        const int row0 = u.pm * 256 + wr * 64 + fr, col0 = u.pn * 256 + wc * 32 + 8 * fq;
        if (u.pn == 24) {
            if (wc == 0) {
#pragma unroll
                for (int ai = 0; ai < 2; ++ai)
#pragma unroll
                    for (int m = 0; m < 4; ++m)
#pragma unroll
                        for (int n = 0; n < 2; ++n) *(f32x4*)(GA + (size_t)(row0 + ai * 128 + m * 16) * 32 + 8 * fq + 4 * n) = acc[ai][0][m][n];
            }
            return;
        }
        const int mode = u.pn < 4 ? 0 : (u.pn < 16 ? 1 : 2);
#pragma unroll
        for (int ai = 0; ai < 2; ++ai)
#pragma unroll
            for (int m = 0; m < 4; ++m)
#pragma unroll
                for (int bj = 0; bj < 2; ++bj) { float r[8];
#pragma unroll
                    for (int n = 0; n < 2; ++n)
#pragma unroll
                        for (int j = 0; j < 4; ++j) { const float x = acc[ai][bj][m][n][j]; r[n * 4 + j] = mode == 0 ? x * 0.0625f : (mode == 1 ? x : silu_fast(x)); }
                    u32x4 w; w.x = pack_bf2(r[0], r[1]); w.y = pack_bf2(r[2], r[3]); w.z = pack_bf2(r[4], r[5]); w.w = pack_bf2(r[6], r[7]);
                    *(u32x4*)(O + (size_t)(row0 + ai * 128 + m * 16) * GLA_NV + col0 + bj * 128) = w; }
    }
};

struct Ctx {
    const float* in[30]; float* out; unsigned char* ws;
    DI const float* x() const { return in[0]; }
    DI bf16_t* X() const { return (bf16_t*)(ws + WS_X); }
    DI bf16_t* HN() const { return (bf16_t*)(ws + WS_HN); }
    DI bf16_t* U() const { return (bf16_t*)(ws + WS_U); }
    DI float* O2() const { return (float*)(ws + WS_O2); }
    DI bf16_t* O4() const { return (bf16_t*)(ws + WS_O2); }
    DI bf16_t* Z2T() const { return (bf16_t*)(ws + WS_O2); }
    DI float* GA() const { return (float*)(ws + WS_GA); }
    DI float* MODV(int l) const { return (float*)(ws + WS_MODV) + (size_t)l * 5 * NMOD * D; }
    DI float* LB() const { return (float*)(ws + WS_LB); }
    DI float* HID2L(int j) const { return (float*)(ws + WS_HID2L) + (size_t)j * SEQ * 64; }
    DI float* HID2C(int j) const { return (float*)(ws + WS_HID2C) + (size_t)j * CL * 64; }
};

DI void transpose_weight(const float* src, bf16_t* dst, int K, int Nsrc, int Ndst, int mode, float* tile  ) {
    const int tid = tidx(), nkt = K / 64, nnt = Ndst / 256, ntiles = nkt * nnt;
    const int kk = tid >> 6, n4 = tid & 63;
    f32x4 r[8];
#define TW_LOAD(tix_) do { const int kt_ = (tix_) % nkt, nt_ = (tix_) / nkt; int sc_ = nt_ * 256 + 4 * n4; \
        if (mode == 1) sc_ = (4 * n4 < 128) ? 128 * nt_ + 4 * n4 : FF + 128 * nt_ + (4 * n4 - 128); \
        _Pragma("unroll") for (int i = 0; i < 8; ++i) r[i] = (sc_ < Nsrc) ? *(const f32x4*)(src + (size_t)(kt_ * 64 + kk + 8 * i) * Nsrc + sc_) : (f32x4){0.f, 0.f, 0.f, 0.f}; } while (0)
    int tix = blockIdx.x;
    if (tix < ntiles) TW_LOAD(tix);
    for (; tix < ntiles; tix += gridDim.x) {
        const int k0 = (tix % nkt) * 64, n0 = (tix / nkt) * 256;
        __syncthreads();
#pragma unroll
        for (int i = 0; i < 8; ++i) *(f32x4*)(tile + (kk + 8 * i) * 260 + 4 * n4) = r[i];
        __syncthreads();
        if (tix + (int)gridDim.x < ntiles) TW_LOAD(tix + (int)gridDim.x);
        {   const int nn = tid >> 1, kh = (tid & 1) * 32; bf16_t* dp = dst + (size_t)(n0 + nn) * K + k0 + kh;
#pragma unroll
            for (int q = 0; q < 4; ++q) { float v[8];
#pragma unroll
                for (int i = 0; i < 8; ++i) v[i] = tile[(kh + 8 * q + i) * 260 + nn];
                u32x4 w; w.x = pack_bf2(v[0], v[1]); w.y = pack_bf2(v[2], v[3]); w.z = pack_bf2(v[4], v[5]); w.w = pack_bf2(v[6], v[7]);
                *(u32x4*)(dp + 8 * q) = w; } }
    }
#undef TW_LOAD
    __syncthreads();
}

DI void modv_items(const Ctx& c, float* lds_f) {
    float* sc = lds_f;
    float* part = lds_f + 5 * D;
    const int tid = tidx(), lane = tid & 63, kq = tid >> 6;
    const int nitems = DEPTH * (NMOD * D / 256);
    bool have_sc = false;
    for (int it = (int)gridDim.x - 1 - (int)blockIdx.x; it < nitems; it += gridDim.x) {
        if (!have_sc) { for (int i = tid; i < 5 * D; i += NTHREADS) { const int r = i / D, k = i % D; const float v = r < 4 ? c.in[1][r * D + k] : c.in[3][k]; sc[i] = silu_f(v); } have_sc = true; }
        __syncthreads();
        const int l = it / (NMOD * D / 256), cb = it % (NMOD * D / 256);
        const float* wp = c.in[4] + (size_t)l * D * (NMOD * D) + cb * 256 + 4 * lane;
        float a[5][4];
#pragma unroll
        for (int r = 0; r < 5; ++r)
#pragma unroll
            for (int j = 0; j < 4; ++j) a[r][j] = 0.f;
#pragma unroll 8
        for (int k = kq; k < D; k += 8) { const float4 w = *(const float4*)(wp + (size_t)k * (NMOD * D));
#pragma unroll
            for (int r = 0; r < 5; ++r) { const float s = sc[r * D + k]; a[r][0] += s * w.x; a[r][1] += s * w.y; a[r][2] += s * w.z; a[r][3] += s * w.w; } }
#pragma unroll
        for (int r = 0; r < 5; ++r)
#pragma unroll
            for (int j = 0; j < 4; ++j) part[(kq * 5 + r) * 256 + 4 * lane + j] = a[r][j];
        __syncthreads();
        for (int o = tid; o < 5 * 256; o += NTHREADS) { const int r = o / 256, n = o % 256; float s = c.in[5][(size_t)l * NMOD * D + cb * 256 + n];
#pragma unroll
            for (int q = 0; q < 8; ++q) s += part[(q * 5 + r) * 256 + n];
            c.MODV(l)[(size_t)r * NMOD * D + cb * 256 + n] = s; }
        __syncthreads();
    }
}

DI void hid2_items(const Ctx& c, float* lds_f) {
    float* zb = lds_f;
    float* h1 = lds_f + 8 * 36;
    const int tid = tidx(), p = tid >> 6, j = tid & 63;
    const int per_layer = (SEQ + CL) / 8, nitems = 2 * per_layer;
    for (int it = blockIdx.x; it < nitems; it += gridDim.x) {
        const int jl = it / per_layer, r = it % per_layer;
        const bool isl = r < SEQ / 8; const int L = isl ? SEQ : CL; const int pos = (isl ? r : r - SEQ / 8) * 8 + p;
        if (j < 33) { float z;
            if (j == 0) z = (float)pos / (float)(L - 1);
            else { const int band = (j <= 16) ? j : j - 16; const int ph = (pos * band) & (L - 1); const float rev = (float)ph / (float)L;
                   z = (j <= 16) ? cosf(6.283185307179586f * rev) : -sinf(6.283185307179586f * rev); }
            zb[p * 36 + j] = z; }
        __syncthreads();
        {   const float* fw1 = c.in[13] + (size_t)jl * 33 * 64; float s = c.in[14][jl * 64 + j];
            for (int i = 0; i < 33; ++i) s += zb[p * 36 + i] * fw1[i * 64 + j];
            h1[p * 64 + j] = sinf(c.in[15][(jl * 2 + 0) * 64 + j] * s); }
        __syncthreads();
        {   const float* fw2 = c.in[16] + (size_t)jl * 64 * 64; float s = c.in[17][jl * 64 + j];
            for (int i = 0; i < 64; ++i) s += h1[p * 64 + i] * fw2[i * 64 + j];
            const float o = sinf(c.in[15][(jl * 2 + 1) * 64 + j] * s);
            (isl ? c.HID2L(jl) : c.HID2C(jl))[(size_t)pos * 64 + j] = o; }
        __syncthreads();
    }
}

DI void prologue_phase(const Ctx& c, unsigned char* lds) {
    float* lf = (float*)lds;
    for (int j = 0; j < 2; ++j) {
        transpose_weight(c.in[11] + (size_t)j * D * HY_N, (bf16_t*)(c.ws + WS_WHYIN) + (size_t)j * HY_N * D, D, HY_N, HY_N, 0, lf);
        transpose_weight(c.in[20] + (size_t)j * D * D, (bf16_t*)(c.ws + WS_WHYOUT) + (size_t)j * D * D, D, D, D, 0, lf);
    }
    transpose_weight(c.in[21], (bf16_t*)(c.ws + WS_WHGIN), D, HG_N, HG_N, 0, lf);
    transpose_weight(c.in[24], (bf16_t*)(c.ws + WS_WHGOUT), D, D, D, 0, lf);
    transpose_weight(c.in[25], (bf16_t*)(c.ws + WS_WGLIN), D, GLA_N, GLA_NP, 0, lf);
    transpose_weight(c.in[29], (bf16_t*)(c.ws + WS_WGLOUT), D, D, D, 0, lf);
    for (int l = 0; l < DEPTH; ++l) {
        transpose_weight(c.in[8] + (size_t)l * D * 2 * FF, (bf16_t*)(c.ws + WS_WFIN) + (size_t)l * 2 * FF * D, D, 2 * FF, 2 * FF, 1, lf);
        transpose_weight(c.in[9] + (size_t)l * FF * D, (bf16_t*)(c.ws + WS_WFOUT) + (size_t)l * D * FF, FF, D, D, 0, lf);
    }
    modv_items(c, lf);
    __syncthreads();
    hid2_items(c, lf);
    for (int i = blockIdx.x * NTHREADS + tidx(); i < 2 * D; i += gridDim.x * NTHREADS) {
        const int dir = i / D, d = i % D; const float* lg = c.in[22] + (size_t)dir * DEPTH * D + d;
        const float l0 = lg[0], l1 = lg[D], l2 = lg[2 * D], l3 = lg[3 * D]; const float mx = fmaxf(fmaxf(l0, l1), fmaxf(l2, l3));
        const float e0 = expf(l0 - mx), e1 = expf(l1 - mx), e2 = expf(l2 - mx), e3 = expf(l3 - mx);
        c.LB()[i] = e1 / (e0 + e1 + e2 + e3);
    }
}

template <bool F32> struct XRawT { typedef float4 type; };
template <> struct XRawT<false> { typedef u32x2 type; };
DI float4 cvt4(const float4& r) { return r; }
DI float4 cvt4(const u32x2& r) { return make_float4(u_as_f(r.x << 16), u_as_f(r.x & 0xffff0000u), u_as_f(r.y << 16), u_as_f(r.y & 0xffff0000u)); }
template <bool F32> DI typename XRawT<F32>::type ldx(const void* p, size_t e) {
    if constexpr (F32) return *(const float4*)((const float*)p + e); else return *(const u32x2*)((const bf16_t*)p + e); }
template <int NP> DI void fold_parts(float4 (&v)[8], const float4 (&gt)[8], const float* Pr) {
    constexpr int NI = 16 / NP;
#pragma unroll
    for (int ib = 0; ib < 8; ib += NI) { float4 p[NI][NP];
#pragma unroll
        for (int q = 0; q < NI; ++q)
#pragma unroll
            for (int k = 0; k < NP; ++k) p[q][k] = *(const float4*)(Pr + (size_t)k * TC * D + (ib + q) * 256);
        MEM_FENCE();
#pragma unroll
        for (int q = 0; q < NI; ++q) { float4 s = make_float4(0.f, 0.f, 0.f, 0.f);
#pragma unroll
            for (int k = 0; k < NP; ++k) { s.x += p[q][k].x; s.y += p[q][k].y; s.z += p[q][k].z; s.w += p[q][k].w; }
            const int i = ib + q; v[i].x += gt[i].x * s.x; v[i].y += gt[i].y * s.y; v[i].z += gt[i].z * s.z; v[i].w += gt[i].w * s.w; } }
}
template <bool LF32, bool CF32>
DI void norm_mod_phase(const void* Xl, const void* Xc, bf16_t* Xcw, const float* g, const float* modv_l, int shift_i, int scale_i, bf16_t* HNp, int nrows, const float* P, int nparts, const float* pgate) {
    typedef typename XRawT<LF32>::type raw_t;
    const int tid_ = tidx(); const int lane = tid_ & 63, wv = tid_ >> 6;
    const int gw = blockIdx.x * 8 + wv, nw = gridDim.x * 8;
    const int nlat = nrows < T ? nrows : T;
    if constexpr (!LF32) {
    const bf16_t* Xb = (const bf16_t*)Xl;
    for (int base = gw * 8; base < nlat; base += nw * 8) {
        const float* mv = modv_l + (size_t)(base / SEQ) * NMOD * D;
        u32x4 nx[4], ny[4];
#pragma unroll
        for (int i = 0; i < 4; ++i) { nx[i] = *(const u32x4*)(Xb + (size_t)base * D + i * 512 + lane * 8); ny[i] = *(const u32x4*)(Xb + (size_t)(base + 1) * D + i * 512 + lane * 8); }
        float4 ca[8], cb[8];
        {   f32x4 ra[12], rb[12];
#pragma unroll
            for (int i = 0; i < 8; ++i) { const int e = (i >> 1) * 512 + lane * 8 + (i & 1) * 4; const f32x4 gq = *(const f32x4*)(g + e), sq = *(const f32x4*)(mv + scale_i * D + e), hq = *(const f32x4*)(mv + shift_i * D + e);
                ra[i] = gq; if (i < 4) ra[8 + i] = sq; else rb[i - 4] = sq; rb[4 + i] = hq; }
            PIN12(ra); PIN12(rb);
#pragma unroll
            for (int i = 0; i < 8; ++i) { const f32x4 gq = ra[i], sq = i < 4 ? ra[8 + i] : rb[i - 4], hq = rb[4 + i];
                ca[i] = make_float4(gq[0] * (1.0f + sq[0]), gq[1] * (1.0f + sq[1]), gq[2] * (1.0f + sq[2]), gq[3] * (1.0f + sq[3])); cb[i] = make_float4(hq[0], hq[1], hq[2], hq[3]); } }
#pragma unroll 2
        for (int r = 0; r < 8; ++r) { const int row = base + r; float4 v[8]; float ss = 0.f;
#pragma unroll
            for (int i = 0; i < 4; ++i) { const u32x4 x = nx[i]; nx[i] = ny[i];
                v[2 * i] = make_float4(u_as_f(x.x << 16), u_as_f(x.x & 0xffff0000u), u_as_f(x.y << 16), u_as_f(x.y & 0xffff0000u));
                v[2 * i + 1] = make_float4(u_as_f(x.z << 16), u_as_f(x.z & 0xffff0000u), u_as_f(x.w << 16), u_as_f(x.w & 0xffff0000u)); }
            if (r < 6) {
#pragma unroll
                for (int i = 0; i < 4; ++i) ny[i] = *(const u32x4*)(Xb + (size_t)(row + 2) * D + i * 512 + lane * 8); }
#pragma unroll
            for (int i = 0; i < 8; ++i) ss += v[i].x * v[i].x + v[i].y * v[i].y + v[i].z * v[i].z + v[i].w * v[i].w;
            ss = wave_sum(ss);
            const float rstd = rsqrtf(ss * (1.0f / D) + RMS_EPS);
#pragma unroll
            for (int i = 0; i < 4; ++i) { const int a = 2 * i, b = 2 * i + 1; u32x4 w;
                w.x = pack_bf2(v[a].x * rstd * ca[a].x + cb[a].x, v[a].y * rstd * ca[a].y + cb[a].y); w.y = pack_bf2(v[a].z * rstd * ca[a].z + cb[a].z, v[a].w * rstd * ca[a].w + cb[a].w);
                w.z = pack_bf2(v[b].x * rstd * ca[b].x + cb[b].x, v[b].y * rstd * ca[b].y + cb[b].y); w.w = pack_bf2(v[b].z * rstd * ca[b].z + cb[b].z, v[b].w * rstd * ca[b].w + cb[b].w);
                *(u32x4*)(HNp + (size_t)row * D + i * 512 + lane * 8) = w; } }
    }
    } else {
    for (int base = gw * 8; base < nlat; base += nw * 8) {
        const float* mv = modv_l + (size_t)(base / SEQ) * NMOD * D;
        float4 ca[8], cb[8];
#pragma unroll
        for (int i = 0; i < 8; ++i) { const int e = i * 256 + lane * 4; const float4 gg = *(const float4*)(g + e), sc = *(const float4*)(mv + scale_i * D + e); cb[i] = *(const float4*)(mv + shift_i * D + e);
            ca[i] = make_float4(gg.x * (1.0f + sc.x), gg.y * (1.0f + sc.y), gg.z * (1.0f + sc.z), gg.w * (1.0f + sc.w)); }
        raw_t nx[8], ny[8];
#pragma unroll
        for (int i = 0; i < 8; ++i) { nx[i] = ldx<LF32>(Xl, (size_t)base * D + i * 256 + lane * 4); ny[i] = ldx<LF32>(Xl, (size_t)(base + 1) * D + i * 256 + lane * 4); }
#pragma unroll 2
        for (int r = 0; r < 8; ++r) { const int row = base + r; float4 v[8]; float ss = 0.f;
#pragma unroll
            for (int i = 0; i < 8; ++i) { v[i] = cvt4(nx[i]); nx[i] = ny[i]; }
            if (r < 6) {
#pragma unroll
                for (int i = 0; i < 8; ++i) ny[i] = ldx<LF32>(Xl, (size_t)(row + 2) * D + i * 256 + lane * 4); }
#pragma unroll
            for (int i = 0; i < 8; ++i) ss += v[i].x * v[i].x + v[i].y * v[i].y + v[i].z * v[i].z + v[i].w * v[i].w;
            ss = wave_sum(ss);
            const float rstd = rsqrtf(ss * (1.0f / D) + RMS_EPS);
#pragma unroll
            for (int i = 0; i < 8; ++i) { const int e = i * 256 + lane * 4;
                u32x2 w; w.x = pack_bf2(v[i].x * rstd * ca[i].x + cb[i].x, v[i].y * rstd * ca[i].y + cb[i].y); w.y = pack_bf2(v[i].z * rstd * ca[i].z + cb[i].z, v[i].w * rstd * ca[i].w + cb[i].w);
                *(u32x2*)(HNp + (size_t)row * D + e) = w; } }
    }
    }
    for (int row = T + gw; row < nrows; row += nw) {
        float4 v[8]; float ss = 0.f;
#pragma unroll
        for (int i = 0; i < 8; ++i) v[i] = cvt4(ldx<CF32>(Xc, (size_t)(row - T) * D + i * 256 + lane * 4));
        if (nparts > 0) {
            float4 gt[8];
#pragma unroll
            for (int i = 0; i < 8; ++i) gt[i] = *(const float4*)(pgate + i * 256 + lane * 4);
            const float* Pr = P + (size_t)(row - T) * D + lane * 4;
            if (nparts == 8) fold_parts<8>(v, gt, Pr); else fold_parts<4>(v, gt, Pr);
#pragma unroll
            for (int i = 0; i < 8; ++i) { u32x2 w; w.x = pack_bf2(v[i].x, v[i].y); w.y = pack_bf2(v[i].z, v[i].w);
                *(u32x2*)(Xcw + (size_t)(row - T) * D + i * 256 + lane * 4) = w; } }
        const float* mv = modv_l + (size_t)NBATCH * NMOD * D;
        f32x4 ra[12], rb[12];
#pragma unroll
        for (int i = 0; i < 8; ++i) { const int e = i * 256 + lane * 4; const f32x4 gq = *(const f32x4*)(g + e), sq = *(const f32x4*)(mv + scale_i * D + e), hq = *(const f32x4*)(mv + shift_i * D + e);
            ra[i] = gq; if (i < 4) ra[8 + i] = sq; else rb[i - 4] = sq; rb[4 + i] = hq; }
#pragma unroll
        for (int i = 0; i < 8; ++i) ss += v[i].x * v[i].x + v[i].y * v[i].y + v[i].z * v[i].z + v[i].w * v[i].w;
        ss = wave_sum(ss);
        const float rstd = rsqrtf(ss * (1.0f / D) + RMS_EPS);
        PIN12(ra); PIN12(rb);
#pragma unroll
        for (int i = 0; i < 8; ++i) { const f32x4 gq = ra[i], sq = i < 4 ? ra[8 + i] : rb[i - 4], hq = rb[4 + i]; const int e = i * 256 + lane * 4;
            u32x2 w; w.x = pack_bf2(v[i].x * rstd * gq[0] * (1.0f + sq[0]) + hq[0], v[i].y * rstd * gq[1] * (1.0f + sq[1]) + hq[1]);
            w.y = pack_bf2(v[i].z * rstd * gq[2] * (1.0f + sq[2]) + hq[2], v[i].w * rstd * gq[3] * (1.0f + sq[3]) + hq[3]);
            *(u32x2*)(HNp + (size_t)row * D + e) = w; }
    }
}
DI void final_norm_phase(const bf16_t* X, const float* g, float* out, int nrows) {
    const int tid_ = tidx(); const int lane = tid_ & 63, wv = tid_ >> 6;
    const int gw = blockIdx.x * 8 + wv, nw = gridDim.x * 8;
    float4 gg[8];
#pragma unroll
    for (int i = 0; i < 8; ++i) gg[i] = *(const float4*)(g + i * 256 + lane * 4);
    for (int base = gw * 8; base < nrows; base += nw * 8) {
        u32x2 nx[8], ny[8];
#pragma unroll
        for (int i = 0; i < 8; ++i) { nx[i] = *(const u32x2*)(X + (size_t)base * D + i * 256 + lane * 4); ny[i] = *(const u32x2*)(X + (size_t)(base + 1) * D + i * 256 + lane * 4); }
#pragma unroll 2
        for (int r = 0; r < 8; ++r) { const int row = base + r; float4 v[8]; float ss = 0.f;
#pragma unroll
            for (int i = 0; i < 8; ++i) { v[i] = cvt4(nx[i]); nx[i] = ny[i]; }
            if (r < 6) {
#pragma unroll
                for (int i = 0; i < 8; ++i) ny[i] = *(const u32x2*)(X + (size_t)(row + 2) * D + i * 256 + lane * 4); }
#pragma unroll
            for (int i = 0; i < 8; ++i) ss += v[i].x * v[i].x + v[i].y * v[i].y + v[i].z * v[i].z + v[i].w * v[i].w;
            ss = wave_sum(ss);
            const float rstd = rsqrtf(ss * (1.0f / D) + RMS_EPS);
#pragma unroll
            for (int i = 0; i < 8; ++i) *(float4*)(out + (size_t)row * D + i * 256 + lane * 4) = make_float4(v[i].x * rstd * gg[i].x, v[i].y * rstd * gg[i].y, v[i].z * rstd * gg[i].z, v[i].w * rstd * gg[i].w); }
    }
}
template <int HS>
DI void headnorm_phase(const bf16_t* O4p, const float* g, const bf16_t* Up, int ldu, int goff, bf16_t* Z, int nrows) {
    const int tid_ = tidx(); const int lane = tid_ & 63, wv = tid_ >> 6;
    for (int row = blockIdx.x * 8 + wv; row < nrows; row += gridDim.x * 8) {
        const bf16_t* o0 = O4p + (size_t)row * D;
        float4 v[8]; float ss[8];
#pragma unroll
        for (int i = 0; i < 8; ++i) { const int e = i * 256 + lane * 4;
            const u16x4 a = *(const u16x4*)(o0 + e), b = *(const u16x4*)(o0 + (size_t)TT * D + e), cc = *(const u16x4*)(o0 + (size_t)2 * TT * D + e), dd = *(const u16x4*)(o0 + (size_t)3 * TT * D + e);
            v[i] = make_float4((bf2f(a[0]) + bf2f(b[0])) + (bf2f(cc[0]) + bf2f(dd[0])), (bf2f(a[1]) + bf2f(b[1])) + (bf2f(cc[1]) + bf2f(dd[1])),
                               (bf2f(a[2]) + bf2f(b[2])) + (bf2f(cc[2]) + bf2f(dd[2])), (bf2f(a[3]) + bf2f(b[3])) + (bf2f(cc[3]) + bf2f(dd[3])));
            ss[i] = v[i].x * v[i].x + v[i].y * v[i].y + v[i].z * v[i].z + v[i].w * v[i].w; }
        float rs[8];
        if (HS == 128) {
#pragma unroll
            for (int i = 0; i < 8; ++i) { float s = ss[i]; s += shfl_xor_f(s, 16); s += shfl_xor_f(s, 8); s += shfl_xor_f(s, 4); s += shfl_xor_f(s, 2); s += shfl_xor_f(s, 1); rs[i] = rsqrtf(s * (1.0f / 128.0f) + RMS_EPS); }
        } else {
#pragma unroll
            for (int i = 0; i < 8; i += 2) { const float s = wave_sum(ss[i] + ss[i + 1]); rs[i] = rs[i + 1] = rsqrtf(s * (1.0f / 512.0f) + RMS_EPS); }
        }
#pragma unroll
        for (int i = 0; i < 8; ++i) { const int e = i * 256 + lane * 4; const float4 gg = *(const float4*)(g + e);
            const u16x4 sg = *(const u16x4*)(Up + (size_t)row * ldu + goff + e);
            u32x2 w; w.x = pack_bf2(v[i].x * rs[i] * gg.x * bf2f(sg[0]), v[i].y * rs[i] * gg.y * bf2f(sg[1]));
            w.y = pack_bf2(v[i].z * rs[i] * gg.z * bf2f(sg[2]), v[i].w * rs[i] * gg.w * bf2f(sg[3]));
            *(u32x2*)(Z + (size_t)row * D + e) = w; }
    }
}
DI void transpose_z_phase(const bf16_t* Z2Tp, bf16_t* Z, int ntok, unsigned char* lds) {
    bf16_t* tile = (bf16_t*)lds;
    const int tid = tidx(), ntt = ntok / 256, ntiles = ntt * (D / 64);
    const int ch = tid >> 3, t8 = tid & 7;
    int tix = blockIdx.x; u32x4 nx[4];
#define TZ_LOAD(t_) do { const bf16_t* p_ = Z2Tp + (size_t)(((t_) / ntt) * 64 + ch) * TT + ((t_) % ntt) * 256 + 8 * t8; \
        _Pragma("unroll") for (int i = 0; i < 4; ++i) nx[i] = *(const u32x4*)(p_ + 64 * i); } while (0)
    if (tix < ntiles) TZ_LOAD(tix);
    for (; tix < ntiles; tix += gridDim.x) {
        const int c0 = (tix / ntt) * 64, t0 = (tix % ntt) * 256;
        __syncthreads();
#pragma unroll
        for (int i = 0; i < 4; ++i) *(u32x4*)(tile + ch * 264 + 64 * i + 8 * t8) = nx[i];
        if (tix + (int)gridDim.x < ntiles) TZ_LOAD(tix + (int)gridDim.x);
        __syncthreads();
        {   const int tok = tid >> 1, hb = (tid & 1) * 32;
#pragma unroll
            for (int q = 0; q < 4; ++q) { unsigned short r[8];
#pragma unroll
                for (int i = 0; i < 8; ++i) r[i] = tile[(hb + 8 * q + i) * 264 + tok];
                u32x4 w; w.x = r[0] | ((unsigned)r[1] << 16); w.y = r[2] | ((unsigned)r[3] << 16); w.z = r[4] | ((unsigned)r[5] << 16); w.w = r[6] | ((unsigned)r[7] << 16);
                *(u32x4*)(Z + (size_t)(t0 + tok) * D + c0 + hb + 8 * q) = w; } }
    }
#undef TZ_LOAD
    __syncthreads();
}

constexpr float LOG2E = 1.4426950408889634f;
template <int DK, int DV, int NH, bool IS_GLA>
DI void scan_prep_phase(const Ctx& c, unsigned char* lds) {
    constexpr int QS = DK + 8, TS = 72, NSEG = NTHREADS / DK, SEGLEN = 64 / NSEG, NCH = DK / 64, NVS = NTHREADS / DV, VLEN = 64 / NVS;
    constexpr int LDU = IS_GLA ? GLA_NV : HG_N, NBHC = 4 * NH * 68;
    bf16_t* qt = (bf16_t*)lds;
    bf16_t* kt = qt + 64 * QS;
    bf16_t* vT = kt + 64 * QS;
    bf16_t* att = vT + DV * TS;
    float* segsum = (float*)(att + 64 * TS);
    float* abuf = segsum + NSEG * DK;
    const int tid = tidx(), lane = tid & 63, w = tid >> 6, fr = lane & 15, fq = lane >> 4;
    const bf16_t* Up = c.U();
    bf16_t* QTg = (bf16_t*)(c.ws + WS_PQT); bf16_t* KTg = (bf16_t*)(c.ws + WS_PKT); bf16_t* VTg = (bf16_t*)(c.ws + WS_PVT); float* EMg = (float*)(c.ws + WS_PEM);
    const int d = tid % DK, seg = tid / DK;
    u32x4 rq[NCH], rk[NCH]; f32x4 ra = (f32x4){0.f, 0.f, 0.f, 0.f};
#define PREP_DECODE(u_, chunk_, dir_, h_, b_, r0_) const int chunk_ = (u_) % 68, dir_ = ((u_) / 68) & 1, h_ = ((u_) / 136) % NH, b_ = (u_) / (136 * NH); \
        const int r0_ = chunk_ < 4 ? T + b_ * CL + 64 * chunk_ : b_ * SEQ + 64 * (chunk_ - 4)
#define PREP_LOAD(u_) do { PREP_DECODE(u_, ch_, di_, hh_, bb_, rr_); \
        const int q0_ = IS_GLA ? hh_ * 256 : hh_ * 128, k0_ = IS_GLA ? 1024 + hh_ * 256 : 6144 + di_ * D + hh_ * 128; \
        _Pragma("unroll") for (int i = 0; i < NCH; ++i) { const int ci = tid + NTHREADS * i, t = ci / (DK / 8), c8 = ci % (DK / 8); \
            rq[i] = *(const u32x4*)(Up + (size_t)(rr_ + t) * LDU + q0_ + 8 * c8); if (!IS_GLA) rk[i] = *(const u32x4*)(Up + (size_t)(rr_ + t) * LDU + k0_ + 8 * c8); } \
        if (IS_GLA && tid < 256) ra = *(const f32x4*)(c.GA() + (size_t)(rr_ + (tid >> 2)) * 32 + di_ * 16 + 4 * (tid & 3)); } while (0)
    if ((int)blockIdx.x < 2 * NBHC) PREP_LOAD((int)blockIdx.x);
    for (int u = blockIdx.x; u < 2 * NBHC; u += gridDim.x) {
        PREP_DECODE(u, chunk, dir, h, b, r0);
        const int bhc = (b * NH + h) * 68 + chunk;
        const int ucv = IS_GLA ? 2048 + h * 512 : 2048 + h * 128;
        float wup[16], bup = 0.f;
        if (IS_GLA) {
#pragma unroll
            for (int r = 0; r < 16; ++r) wup[r] = c.in[26][((size_t)dir * 16 + r) * 1024 + h * 256 + d];
            bup = c.in[27][(size_t)dir * 1024 + h * 256 + d]; }
        u32x4 kk[NCH];
        if (IS_GLA) {
#pragma unroll
            for (int i = 0; i < NCH; ++i) { const int ci = tid + NTHREADS * i, t = ci / (DK / 8), c8 = ci % (DK / 8); kk[i] = *(const u32x4*)(Up + (size_t)(r0 + t) * LDU + 1024 + h * 256 + 8 * c8); } }
        lds_barrier();
#pragma unroll
        for (int i = 0; i < NCH; ++i) { const int ci = tid + NTHREADS * i, t = ci / (DK / 8), c8 = ci % (DK / 8);
            *(u32x4*)(qt + t * QS + 8 * c8) = rq[i];
            *(u32x4*)(kt + t * QS + 8 * c8) = IS_GLA ? kk[i] : rk[i]; }
        if (IS_GLA && tid < 256) *(f32x4*)(abuf + (tid >> 2) * 16 + 4 * (tid & 3)) = ra;
        unsigned short ev[VLEN];
        {   const int vv = tid % DV, vs = tid / DV; const bf16_t* vp = Up + (size_t)(r0 + vs * VLEN) * LDU + ucv + vv;
#pragma unroll
            for (int i = 0; i < VLEN; ++i) ev[i] = vp[(size_t)i * LDU]; }
        if (u + (int)gridDim.x < 2 * NBHC) PREP_LOAD(u + (int)gridDim.x);
        lds_barrier();
        float cs[SEGLEN];
        {   float run = 0.f;
#pragma unroll
            for (int ii = 0; ii < SEGLEN; ++ii) { const int i = dir ? SEGLEN - 1 - ii : ii; const int t = seg * SEGLEN + i; float g2;
                if (IS_GLA) { float xx = bup;
#pragma unroll
                    for (int r4 = 0; r4 < 4; ++r4) { const f32x4 av = *(const f32x4*)(abuf + t * 16 + 4 * r4);
                        xx += av[0] * wup[4 * r4] + av[1] * wup[4 * r4 + 1] + av[2] * wup[4 * r4 + 2] + av[3] * wup[4 * r4 + 3]; }
                    g2 = (fminf(xx, 0.f) * LOG2E - flog2(1.0f + fexp2(-fabsf(xx) * LOG2E))) * 0.0625f; }
                else g2 = bf2f(kt[t * QS + d]) * LOG2E;
                run += g2; cs[i] = run; }
            segsum[seg * DK + d] = run; }
        lds_barrier();
        {   float prefix = 0.f, bmid = 0.f, btot = 0.f;
#pragma unroll
            for (int s = 0; s < NSEG; ++s) { const float v = segsum[s * DK + d]; const bool before = dir ? (s > seg) : (s < seg), first_half = dir ? (s >= NSEG / 2) : (s < NSEG / 2);
                if (before) prefix += v; if (first_half) bmid += v; btot += v; }
            unsigned kpk[SEGLEN / 2];
#pragma unroll
            for (int i = 0; i < SEGLEN; ++i) { const int t = seg * SEGLEN + i; const float bc = prefix + cs[i];
                const float kraw = bf2f(kt[t * QS + d]); const float kv = IS_GLA ? kraw : 1.0f - fexp2(kraw * LOG2E);
                const float qv = bf2f(qt[t * QS + d]);
                const bf16_t qb = f2bf(qv * fexp2(fminf(bc - bmid, 115.f))), kb = f2bf(kv * fexp2(fminf(bmid - bc, 115.f)));
                qt[t * QS + d] = qb; kt[t * QS + d] = kb;
                if (i & 1) kpk[i / 2] |= (unsigned)kb << 16; else kpk[i / 2] = kb; }
            bf16_t* kg = KTg + ((size_t)dir * NBHC + bhc) * (DK * 64) + (size_t)d * 64 + seg * SEGLEN;
#pragma unroll
            for (int i8 = 0; i8 < SEGLEN / 8; ++i8) { u32x4 pk; pk.x = kpk[4 * i8]; pk.y = kpk[4 * i8 + 1]; pk.z = kpk[4 * i8 + 2]; pk.w = kpk[4 * i8 + 3]; *(u32x4*)(kg + 8 * i8) = pk; }
            if (seg == 0) { float* em = EMg + ((size_t)dir * NBHC + bhc) * (2 * DK); em[d] = fexp2(bmid); em[DK + d] = fexp2(btot - bmid); } }
        lds_barrier();
        {   const int tt = w & 3, st0 = 2 * (w >> 2);
            f32x4 a0 = (f32x4){0.f, 0.f, 0.f, 0.f}, a1 = a0;
#pragma unroll
            for (int k0 = 0; k0 < DK; k0 += 32) { const bf16x8 y = *(const bf16x8*)(qt + (16 * tt + fr) * QS + k0 + 8 * fq);
                const bf16x8 x0 = *(const bf16x8*)(kt + (16 * st0 + fr) * QS + k0 + 8 * fq), x1 = *(const bf16x8*)(kt + (16 * (st0 + 1) + fr) * QS + k0 + 8 * fq);
                a0 = mma16(x0, y, a0); a1 = mma16(x1, y, a1); }
            const int t = 16 * tt + fr;
#pragma unroll
            for (int q = 0; q < 2; ++q) { const f32x4 a = q ? a1 : a0; const int s0 = 16 * (st0 + q) + 4 * fq; float m[4];
#pragma unroll
                for (int jj = 0; jj < 4; ++jj) m[jj] = (dir ? (s0 + jj >= t) : (s0 + jj <= t)) ? a[jj] : 0.f;
                u32x2 ww; ww.x = pack_bf2(m[0], m[1]); ww.y = pack_bf2(m[2], m[3]); *(u32x2*)(att + t * TS + s0) = ww; } }
#pragma unroll
        for (int i = 0; i < NCH; ++i) { const int ci = tid + NTHREADS * i, t = ci / (DK / 8), c8 = ci % (DK / 8);
            *(u32x4*)(QTg + ((size_t)dir * TT + r0 + t) * (NH * DK) + h * DK + 8 * c8) = *(const u32x4*)(qt + t * QS + 8 * c8); }
        {   const int vv = tid % DV, vs = tid / DV;
#pragma unroll
            for (int i8 = 0; i8 < VLEN / 8; ++i8) { u32x4 pk; pk.x = ev[8 * i8] | ((unsigned)ev[8 * i8 + 1] << 16); pk.y = ev[8 * i8 + 2] | ((unsigned)ev[8 * i8 + 3] << 16);
                pk.z = ev[8 * i8 + 4] | ((unsigned)ev[8 * i8 + 5] << 16); pk.w = ev[8 * i8 + 6] | ((unsigned)ev[8 * i8 + 7] << 16);
                *(u32x4*)(vT + vv * TS + vs * VLEN + 8 * i8) = pk; } }
        lds_barrier();
        if (dir == 0) {
#pragma unroll
            for (int i = 0; i < DV / 64; ++i) { const int ci = tid + NTHREADS * i, vv = ci >> 3, c8 = ci & 7;
                *(u32x4*)(VTg + (size_t)bhc * (DV * 64) + vv * 64 + 8 * c8) = *(const u32x4*)(vT + vv * TS + 8 * c8); } }
        {   const int tt = w & 3, vg = (w >> 2) * (DV / 32);
            const bf16x8 y0 = *(const bf16x8*)(att + (16 * tt + fr) * TS + 8 * fq), y1 = *(const bf16x8*)(att + (16 * tt + fr) * TS + 32 + 8 * fq);
            bf16_t* op = c.O4() + (size_t)(dir * 2) * TT * D + (size_t)(r0 + 16 * tt + fr) * D + h * DV + 4 * fq;
#pragma unroll 4
            for (int v = 0; v < DV / 32; ++v) { const int vt = vg + v;
                const bf16x8 x0 = *(const bf16x8*)(vT + (16 * vt + fr) * TS + 8 * fq), x1 = *(const bf16x8*)(vT + (16 * vt + fr) * TS + 32 + 8 * fq);
                f32x4 o = mma16(x0, y0, (f32x4){0.f, 0.f, 0.f, 0.f}); o = mma16(x1, y1, o);
                u32x2 ww; ww.x = pack_bf2(o[0], o[1]); ww.y = pack_bf2(o[2], o[3]); *(u32x2*)(op + 16 * vt) = ww; } }
    }
#undef PREP_DECODE
#undef PREP_LOAD
}

template <int DK, int DV, int NH>
DI void scan_seq_phase(const Ctx& c, unsigned char* lds) {
    constexpr int QS = DK + 8, TS = 72, NCH = DK / 64, NDTW = DK / 128, NSL = DV / 64, NBHC = 4 * NH * 68;
    bf16_t* qt = (bf16_t*)lds;
    bf16_t* ktT = qt + 64 * QS;
    bf16_t* vTs = ktT + DK * TS;
    bf16_t* ST = vTs + 64 * TS;
    float* em = (float*)(ST + 64 * QS);
    const int tid = tidx(), lane = tid & 63, w = tid >> 6, fr = lane & 15, fq = lane >> 4;
    const bf16_t* QTg = (const bf16_t*)(c.ws + WS_PQT); const bf16_t* KTg = (const bf16_t*)(c.ws + WS_PKT); const bf16_t* VTg = (const bf16_t*)(c.ws + WS_PVT); const float* EMg = (const float*)(c.ws + WS_PEM);
    for (int cblk = blockIdx.x; cblk < 256; cblk += gridDim.x) {
        const int chain = (gridDim.x == 256) ? ((cblk & 7) * 32 + (cblk >> 3)) : cblk;
        const int sl = chain % NSL, dir = (chain / NSL) & 1, h = (chain / (2 * NSL)) % NH, b = chain / (2 * NSL * NH);
        f32x4 Sacc[NDTW][4];
#pragma unroll
        for (int i = 0; i < NDTW; ++i)
#pragma unroll
            for (int v = 0; v < 4; ++v) Sacc[i][v] = (f32x4){0.f, 0.f, 0.f, 0.f};
        u32x4 rqA[NCH], rkA[NCH], rvA, rqB[NCH], rkB[NCH], rvB; f32x4 reA = (f32x4){0.f, 0.f, 0.f, 0.f}, reB = reA;
#define SEQ_CIDX(n) (((n) < 4) ? (dir ? 3 - (n) : (n)) : 4 + (dir ? 63 - ((n) - 4) : ((n) - 4)))
#define SEQ_ROW0(ci) (((ci) < 4) ? (T + b * CL + 64 * (ci)) : (b * SEQ + 64 * ((ci) - 4)))
#define SEQ_LOAD(S_, n) do { const int ci_ = SEQ_CIDX(n), r0_ = SEQ_ROW0(ci_); const size_t bhc_ = (size_t)(b * NH + h) * 68 + ci_; \
            _Pragma("unroll") for (int i = 0; i < NCH; ++i) { const int cx = tid + NTHREADS * i; \
                rq##S_[i] = *(const u32x4*)(QTg + ((size_t)dir * TT + r0_ + cx / (DK / 8)) * (NH * DK) + h * DK + 8 * (cx % (DK / 8))); \
                rk##S_[i] = *(const u32x4*)(KTg + ((size_t)dir * NBHC + bhc_) * (DK * 64) + (size_t)cx * 8); } \
            rv##S_ = *(const u32x4*)(VTg + bhc_ * (DV * 64) + (size_t)(sl * 64) * 64 + (size_t)tid * 8); \
            if (tid < DK / 2) re##S_ = *(const f32x4*)(EMg + ((size_t)dir * NBHC + bhc_) * (2 * DK) + 4 * tid); } while (0)
#define SEQ_STAGE(S_) do { \
            _Pragma("unroll") for (int i = 0; i < NCH; ++i) { const int cx = tid + NTHREADS * i; \
                *(u32x4*)(qt + (cx / (DK / 8)) * QS + 8 * (cx % (DK / 8))) = rq##S_[i]; *(u32x4*)(ktT + (cx >> 3) * TS + 8 * (cx & 7)) = rk##S_[i]; } \
            *(u32x4*)(vTs + (tid >> 3) * TS + 8 * (tid & 7)) = rv##S_; \
            if (tid < DK / 2) *(f32x4*)(em + 4 * tid) = re##S_; } while (0)
#define SEQ_STEP(n_) do { \
            const int r0 = SEQ_ROW0(SEQ_CIDX(n_)); const int tt = w & 3, vt0 = 2 * (w >> 2); \
            bf16_t* op = c.O4() + (size_t)(dir * 2 + 1) * TT * D + (size_t)(r0 + 16 * tt + fr) * D + h * DV + sl * 64 + 4 * fq; \
            _Pragma("unroll") for (int i = 0; i < NDTW; ++i) { const int dd = 16 * (w * NDTW + i) + fr; const float e1 = em[dd]; \
                _Pragma("unroll") for (int v = 0; v < 4; ++v) { Sacc[i][v] *= e1; \
                    _Pragma("unroll") for (int jj = 0; jj < 4; ++jj) ST[(16 * v + 4 * fq + jj) * QS + dd] = f2bf(Sacc[i][v][jj]); } } \
            lds_barrier(); \
            {   f32x4 o0 = (f32x4){0.f, 0.f, 0.f, 0.f}, o1 = o0; \
                _Pragma("unroll") for (int k0 = 0; k0 < DK; k0 += 32) { const bf16x8 y = *(const bf16x8*)(qt + (16 * tt + fr) * QS + k0 + 8 * fq); \
                    const bf16x8 x0 = *(const bf16x8*)(ST + (16 * vt0 + fr) * QS + k0 + 8 * fq), x1 = *(const bf16x8*)(ST + (16 * (vt0 + 1) + fr) * QS + k0 + 8 * fq); \
                    o0 = mma16(x0, y, o0); o1 = mma16(x1, y, o1); } \
                u32x2 w0, w1; w0.x = pack_bf2(o0[0], o0[1]); w0.y = pack_bf2(o0[2], o0[3]); w1.x = pack_bf2(o1[0], o1[1]); w1.y = pack_bf2(o1[2], o1[3]); \
                *(u32x2*)(op + 16 * vt0) = w0; *(u32x2*)(op + 16 * (vt0 + 1)) = w1; } \
            _Pragma("unroll") for (int i = 0; i < NDTW; ++i) { const int dt = w * NDTW + i; \
                _Pragma("unroll") for (int k0 = 0; k0 < 64; k0 += 32) { const bf16x8 y = *(const bf16x8*)(ktT + (16 * dt + fr) * TS + k0 + 8 * fq); \
                    _Pragma("unroll") for (int v = 0; v < 4; ++v) { const bf16x8 x = *(const bf16x8*)(vTs + (16 * v + fr) * TS + k0 + 8 * fq); Sacc[i][v] = mma16(x, y, Sacc[i][v]); } } \
                const float e2 = em[DK + 16 * dt + fr]; \
                _Pragma("unroll") for (int v = 0; v < 4; ++v) Sacc[i][v] *= e2; } \
            lds_barrier(); } while (0)
        SEQ_LOAD(A, 0); SEQ_LOAD(B, 1);
        lds_barrier();
        SEQ_STAGE(A);
        lds_barrier();
#pragma unroll 1
        for (int n = 0; n < 68; n += 2) {
            if (n + 2 < 68) SEQ_LOAD(A, n + 2);
            SEQ_STEP(n);
            SEQ_STAGE(B); lds_barrier();
            if (n + 3 < 68) SEQ_LOAD(B, n + 3);
            SEQ_STEP(n + 1);
            if (n + 2 < 68) { SEQ_STAGE(A); lds_barrier(); }
        }
#undef SEQ_STEP
#undef SEQ_CIDX
#undef SEQ_ROW0
#undef SEQ_LOAD
#undef SEQ_STAGE
    }
}

struct cpx { float re, im; };
DI cpx cmul(cpx a, cpx b) { return {a.re * b.re - a.im * b.im, a.re * b.im + a.im * b.re}; }
DI cpx cmulc(cpx a, cpx b) { return {a.re * b.re + a.im * b.im, a.im * b.re - a.re * b.im}; }
DI cpx cadd(cpx a, cpx b) { return {a.re + b.re, a.im + b.im}; }
DI cpx csub(cpx a, cpx b) { return {a.re - b.re, a.im - b.im}; }
DI int PADI(int i) { return i + 2 * (i >> 5); }
constexpr int FFT_N = 8192, FFT_NP = FFT_N + FFT_N / 16;
DI int brev4(int j) { return ((j & 1) << 3) | ((j & 2) << 1) | ((j & 4) >> 1) | ((j & 8) >> 3); }
DI cpx w16(int k) {
    const float c1 = 0.92387953251128674f, s1 = 0.38268343236508977f, h = 0.70710678118654752f;
    switch (k & 7) { case 0: return {1.f, 0.f}; case 1: return {c1, -s1}; case 2: return {h, -h}; case 3: return {s1, -c1}; case 4: return {0.f, -1.f}; case 5: return {-s1, -c1}; case 6: return {-h, -h}; default: return {-c1, -s1}; }
}
DI void dft16_dif(cpx (&v)[16]) {
#pragma unroll
    for (int s = 0; s < 4; ++s) { const int half = 8 >> s;
#pragma unroll
        for (int blk = 0; blk < 16; blk += 2 * half)
#pragma unroll
            for (int j = 0; j < half; ++j) { const cpx a = v[blk + j], b = v[blk + j + half]; v[blk + j] = cadd(a, b); const cpx dd = csub(a, b);
                v[blk + j + half] = (j == 0) ? dd : cmul(dd, w16(j * (8 / half))); } }
}
DI void dft16_dit_inv(cpx (&v)[16]) {
#pragma unroll
    for (int s = 3; s >= 0; --s) { const int half = 8 >> s;
#pragma unroll
        for (int blk = 0; blk < 16; blk += 2 * half)
#pragma unroll
            for (int j = 0; j < half; ++j) { const cpx a = v[blk + j]; const cpx b = (j == 0) ? v[blk + j + half] : cmulc(v[blk + j + half], w16(j * (8 / half)));
                v[blk + j] = cadd(a, b); v[blk + j + half] = csub(a, b); } }
}
template <int SP> DI void fft_fwd_pass_store(cpx (&v)[16], cpx* p, float th) {
    dft16_dif(v);
    th = pin_f(th);
    const cpx w1 = {cos_rev(th), -sin_rev(th)};
    cpx wp = w1;
    p[0] = v[0];
#pragma unroll
    for (int k1 = 1; k1 < 16; ++k1) { p[k1 * SP] = cmul(v[brev4(k1)], wp); if (k1 < 15) wp = cmul(wp, w1); }
}
template <int SP> DI void fft_load16(cpx (&v)[16], const cpx* p) {
#pragma unroll
    for (int n1 = 0; n1 < 16; ++n1) v[n1] = p[n1 * SP];
}
template <int SP> DI void fft_inv_pass_load(cpx (&v)[16], const cpx* p, float th) {
    th = pin_f(th);
    const cpx w1 = {cos_rev(th), -sin_rev(th)};
    cpx wp = w1;
    v[0] = p[0];
#pragma unroll
    for (int k1 = 1; k1 < 16; ++k1) { v[brev4(k1)] = cmulc(p[k1 * SP], wp); if (k1 < 15) wp = cmul(wp, w1); }
    dft16_dit_inv(v);
}
template <int SP> DI void fft_store16(const cpx (&v)[16], cpx* p) {
#pragma unroll
    for (int n1 = 0; n1 < 16; ++n1) p[n1 * SP] = v[n1];
}
DI void fft_forward(cpx (&v)[16], cpx* buf, bool last_pair_pass) {
    const int tid = tidx();
    fft_fwd_pass_store<544>(v, buf + PADI(tid), (float)tid * (1.0f / 8192.0f));
    __syncthreads();
    { cpx* p = buf + PADI((tid >> 5) * 512 + (tid & 31)); fft_load16<34>(v, p); fft_fwd_pass_store<34>(v, p, (float)(tid & 31) * (1.0f / 512.0f)); }
    __syncthreads();
    { cpx* p = buf + PADI((tid >> 1) * 32 + (tid & 1)); fft_load16<2>(v, p); fft_fwd_pass_store<2>(v, p, (float)(tid & 1) * (1.0f / 32.0f)); }
    __syncthreads();
    if (last_pair_pass) {
        cpx* p = buf + PADI(2 * tid);
#pragma unroll
        for (int jx = 0; jx < 8; ++jx) { const cpx a = p[jx * 1088], b = p[jx * 1088 + 1]; p[jx * 1088] = cadd(a, b); p[jx * 1088 + 1] = csub(a, b); }
        __syncthreads();
    }
}
DI void fft_mul_inverse(cpx (&v)[16], cpx* A, const cpx* Hs) {
    const int tid = tidx();
    {   cpx* p = A + PADI(2 * tid); const cpx* hp = Hs + PADI(2 * tid);
#pragma unroll
        for (int jx = 0; jx < 8; ++jx) { const cpx a = p[jx * 1088], b = p[jx * 1088 + 1];
            const cpx P = cmul(cadd(a, b), hp[jx * 1088]), Q = cmul(csub(a, b), hp[jx * 1088 + 1]); p[jx * 1088] = cadd(P, Q); p[jx * 1088 + 1] = csub(P, Q); } }
    __syncthreads();
    { cpx* p = A + PADI((tid >> 1) * 32 + (tid & 1)); fft_inv_pass_load<2>(v, p, (float)(tid & 1) * (1.0f / 32.0f)); fft_store16<2>(v, p); }
    __syncthreads();
    { cpx* p = A + PADI((tid >> 5) * 512 + (tid & 31)); fft_inv_pass_load<34>(v, p, (float)(tid & 31) * (1.0f / 512.0f)); fft_store16<34>(v, p); }
    __syncthreads();
    fft_inv_pass_load<544>(v, A + PADI(tid), (float)tid * (1.0f / 8192.0f));
    __syncthreads();
}
template <int SP> DI void fft2_fwd_pass_store(cpx (&v0)[16], cpx (&v1)[16], cpx* p0, cpx* p1, float th) {
    dft16_dif(v0); dft16_dif(v1);
    th = pin_f(th);
    const cpx w1 = {cos_rev(th), -sin_rev(th)};
    cpx wp = w1;
    p0[0] = v0[0]; p1[0] = v1[0];
#pragma unroll
    for (int k1 = 1; k1 < 16; ++k1) { p0[k1 * SP] = cmul(v0[brev4(k1)], wp); p1[k1 * SP] = cmul(v1[brev4(k1)], wp); if (k1 < 15) wp = cmul(wp, w1); }
}
template <int SP> DI void fft2_inv_pass_load(cpx (&v0)[16], cpx (&v1)[16], const cpx* p0, const cpx* p1, float th) {
    th = pin_f(th);
    const cpx w1 = {cos_rev(th), -sin_rev(th)};
    cpx wp = w1;
    v0[0] = p0[0]; v1[0] = p1[0];
#pragma unroll
    for (int k1 = 1; k1 < 16; ++k1) { v0[brev4(k1)] = cmulc(p0[k1 * SP], wp); v1[brev4(k1)] = cmulc(p1[k1 * SP], wp); if (k1 < 15) wp = cmul(wp, w1); }
    dft16_dit_inv(v0); dft16_dit_inv(v1);
}
DI cpx cpx_swap(cpx v) { return {lane_xor1(v.re), lane_xor1(v.im)}; }
DI void fft_filter(cpx (&v)[16], cpx* buf, cpx (&H)[16]) {
    const int tid = tidx();
    fft_fwd_pass_store<544>(v, buf + PADI(tid), (float)tid * (1.0f / 8192.0f));
    lds_barrier();
    { cpx* p = buf + PADI((tid >> 5) * 512 + (tid & 31)); fft_load16<34>(v, p); fft_fwd_pass_store<34>(v, p, (float)(tid & 31) * (1.0f / 512.0f)); }
    lds_barrier();
    fft_load16<2>(v, buf + PADI((tid >> 1) * 32 + (tid & 1)));
    dft16_dif(v);
    const float sgn = (tid & 1) ? -1.0f : 1.0f; const float th = pin_f((float)(tid & 1) * (1.0f / 32.0f));
    const cpx w1 = {cos_rev(th), -sin_rev(th)}; cpx wp = w1;
#pragma unroll
    for (int k1 = 0; k1 < 16; ++k1) { cpx y = v[brev4(k1)]; if (k1 > 0) { y = cmul(y, wp); if (k1 < 15) wp = cmul(wp, w1); }
        const cpx o = cpx_swap(y); H[k1] = {o.re + sgn * y.re, o.im + sgn * y.im}; }
    lds_barrier();
}
DI void fft2_conv(cpx (&v0)[16], cpx (&v1)[16], cpx* A0, cpx* A1, const cpx (&H)[16]) {
    const int tid = tidx();
    {   const int o = PADI(tid); fft2_fwd_pass_store<544>(v0, v1, A0 + o, A1 + o, (float)tid * (1.0f / 8192.0f)); }
    __syncthreads();
    {   const int o = PADI((tid >> 5) * 512 + (tid & 31)); fft_load16<34>(v0, A0 + o); fft_load16<34>(v1, A1 + o); fft2_fwd_pass_store<34>(v0, v1, A0 + o, A1 + o, (float)(tid & 31) * (1.0f / 512.0f)); }
    __syncthreads();
    {   const int o = PADI((tid >> 1) * 32 + (tid & 1)); fft_load16<2>(v0, A0 + o); fft_load16<2>(v1, A1 + o);
        dft16_dif(v0); dft16_dif(v1);
        const float sgn = (tid & 1) ? -1.0f : 1.0f; const float th = pin_f((float)(tid & 1) * (1.0f / 32.0f));
        const cpx w1 = {cos_rev(th), -sin_rev(th)}; cpx wp = w1;
#pragma unroll
        for (int k1 = 0; k1 < 16; ++k1) { cpx y0 = v0[brev4(k1)], y1 = v1[brev4(k1)];
            if (k1 > 0) { y0 = cmul(y0, wp); y1 = cmul(y1, wp); }
            const cpx o0 = cpx_swap(y0), o1 = cpx_swap(y1);
            const cpx R0 = cmul((cpx){o0.re + sgn * y0.re, o0.im + sgn * y0.im}, H[k1]), R1 = cmul((cpx){o1.re + sgn * y1.re, o1.im + sgn * y1.im}, H[k1]);
            const cpx q0 = cpx_swap(R0), q1 = cpx_swap(R1);
            cpx z0 = {q0.re + sgn * R0.re, q0.im + sgn * R0.im}, z1 = {q1.re + sgn * R1.re, q1.im + sgn * R1.im};
            if (k1 > 0) { z0 = cmulc(z0, wp); z1 = cmulc(z1, wp); if (k1 < 15) wp = cmul(wp, w1); }
            PIN4(z0.re, z0.im, z1.re, z1.im);
            v0[brev4(k1)] = z0; v1[brev4(k1)] = z1; }
        dft16_dit_inv(v0); dft16_dit_inv(v1);
        fft_store16<2>(v0, A0 + o); fft_store16<2>(v1, A1 + o); }
    __syncthreads();
    {   const int o = PADI((tid >> 5) * 512 + (tid & 31)); fft2_inv_pass_load<34>(v0, v1, A0 + o, A1 + o, (float)(tid & 31) * (1.0f / 512.0f)); fft_store16<34>(v0, A0 + o); fft_store16<34>(v1, A1 + o); }
    __syncthreads();
    {   const int o = PADI(tid); fft2_inv_pass_load<544>(v0, v1, A0 + o, A1 + o, (float)tid * (1.0f / 8192.0f)); }
    __syncthreads();
}
DI float conv3_at(const bf16_t* row, int pos, int W, float w0, float w1, float w2) {
    const int cc = pos & (W - 1);
    const float u0 = cc > 0 ? bf2f(row[pos - 1]) : 0.f, u1 = bf2f(row[pos]), u2 = cc < W - 1 ? bf2f(row[pos + 1]) : 0.f;
    return w0 * u0 + w1 * u1 + w2 * u2;
}
DI float conv3_wave(const bf16_t* row, int pos, float w0, float w1, float w2) {
    const float u1 = bf2f(row[pos]);
    return w0 * lane_prev(u1) + w1 * u1 + w2 * lane_next(u1);
}
DI float block_sum_lds(float v, float* red  ) {
    v = wave_sum(v);
    lds_barrier();
    { const int t_ = tidx(); if ((t_ & 63) == 0) red[t_ >> 6] = v; }
    lds_barrier();
    float s = 0.f;
#pragma unroll
    for (int i = 0; i < 8; ++i) s += red[i];
    return s;
}
DI float block_sum(float v, float* red  ) {
    v = wave_sum(v);
    __syncthreads();
    { const int t_ = tidx(); if ((t_ & 63) == 0) red[t_ >> 6] = v; }
    __syncthreads();
    float s = 0.f;
#pragma unroll
    for (int i = 0; i < 8; ++i) s += red[i];
    return s;
}
constexpr float HY_DMIN = -3.0701134573253945f, HY_DMAX = -15.350567286626973f;

DI void hyena_conv_phase(const Ctx& c, int jl, bool need_ctx, unsigned char* lds) {
    cpx* A = (cpx*)lds; cpx* B = A + FFT_NP;
    float* fwc = (float*)(B + FFT_NP);
    float* red = fwc + 256;
    const int tid = tidx();
    const bf16_t* UT = c.U(); bf16_t* Z2 = c.Z2T();
    const float* fwout = c.in[18] + (size_t)jl * 64 * (4 * D);
    const float* cw = c.in[12] + (size_t)jl * 3 * HY_N;
    const float* hid2 = c.HID2L(jl);
    float* scr = (float*)(c.ws + WS_HYS + (size_t)(blockIdx.x & 255) * HYS_PER_BLOCK);
    float* hts = (float*)(c.ws + WS_HTS) + (size_t)(blockIdx.x & 255) * (8 * 4 * SEQ);
    {   bf16_t* fwh = (bf16_t*)lds;
        bf16_t* fwl = fwh + 32 * 72;
        float* dl = (float*)(fwl + 32 * 72);
        const int lane = tid & 63, w = tid >> 6, fr = lane & 15, fq = lane >> 4;
        __syncthreads();
        for (int idx = tid; idx < 32 * 64; idx += NTHREADS) { const int col = idx >> 6, j = idx & 63, k = col >> 2, q = col & 3; const int ch = blockIdx.x + k * gridDim.x;
            const float wv = ch < D ? fwout[(size_t)j * (4 * D) + q * D + ch] : 0.f; const bf16_t hi = f2bf(wv);
            fwh[col * 72 + j] = hi; fwl[col * 72 + j] = f2bf(wv - bf2f(hi)); }
        if (tid < 8) { const int ch = blockIdx.x + tid * gridDim.x; dl[tid] = fabsf(HY_DMIN + (HY_DMAX - HY_DMIN) * (float)ch / (float)(D - 1)); }
        __syncthreads();
        bf16x8 bh[2][2], bl[2][2];
#pragma unroll
        for (int ct = 0; ct < 2; ++ct)
#pragma unroll
            for (int s2 = 0; s2 < 2; ++s2) { bh[ct][s2] = *(const bf16x8*)(fwh + (16 * ct + fr) * 72 + 32 * s2 + 8 * fq); bl[ct][s2] = *(const bf16x8*)(fwl + (16 * ct + fr) * 72 + 32 * s2 + 8 * fq); }
        constexpr int NIT = SEQ / 16 / 8;
        f32x4 xb[4][4];
#define P1_LOAD(j_, it_) do { const float* hr_ = hid2 + (size_t)(16 * (w + 8 * (it_)) + fr) * 64 + 8 * fq; \
            xb[j_][0] = *(const f32x4*)(hr_); xb[j_][1] = *(const f32x4*)(hr_ + 4); xb[j_][2] = *(const f32x4*)(hr_ + 32); xb[j_][3] = *(const f32x4*)(hr_ + 36); } while (0)
#pragma unroll
        for (int j = 0; j < 4; ++j) P1_LOAD(j, j);
#pragma unroll 1
        for (int it = 0; it < NIT; it += 4) {
#pragma unroll
            for (int j = 0; j < 4; ++j) { const int p0 = 16 * (w + 8 * (it + j));
                const f32x4 xa[4] = {xb[j][0], xb[j][1], xb[j][2], xb[j][3]};
                if (it + 4 < NIT) P1_LOAD(j, it + j + 4);
                bf16x8 ah[2], al[2];
#pragma unroll
                for (int s2 = 0; s2 < 2; ++s2) { const f32x4 x0 = xa[2 * s2], x1 = xa[2 * s2 + 1]; u32x4 ph, pl;
                    ph.x = pack_bf2(x0[0], x0[1]); ph.y = pack_bf2(x0[2], x0[3]); ph.z = pack_bf2(x1[0], x1[1]); ph.w = pack_bf2(x1[2], x1[3]);
                    pl.x = pack_bf2(x0[0] - u_as_f(ph.x << 16), x0[1] - u_as_f(ph.x & 0xffff0000u)); pl.y = pack_bf2(x0[2] - u_as_f(ph.y << 16), x0[3] - u_as_f(ph.y & 0xffff0000u));
                    pl.z = pack_bf2(x1[0] - u_as_f(ph.z << 16), x1[1] - u_as_f(ph.z & 0xffff0000u)); pl.w = pack_bf2(x1[2] - u_as_f(ph.w << 16), x1[3] - u_as_f(ph.w & 0xffff0000u));
                    ah[s2] = __builtin_bit_cast(bf16x8, ph); al[s2] = __builtin_bit_cast(bf16x8, pl); }
#pragma unroll
                for (int ct = 0; ct < 2; ++ct) { f32x4 acc = (f32x4){0.f, 0.f, 0.f, 0.f};
#pragma unroll
                    for (int s2 = 0; s2 < 2; ++s2) { acc = mma16(ah[s2], bh[ct][s2], acc); acc = mma16(ah[s2], bl[ct][s2], acc); acc = mma16(al[s2], bh[ct][s2], acc); }
                    const int col = 16 * ct + fr, k = col >> 2; const float ck = dl[k] * (-LOG2E / (float)(SEQ - 1)); const int pb = p0 + 4 * fq;
                    f32x4 o;
#pragma unroll
                    for (int jj = 0; jj < 4; ++jj) o[jj] = acc[jj] * fexp2((float)(pb + jj) * ck);
                    *(f32x4*)(hts + (size_t)col * SEQ + pb) = o; } } }
#undef P1_LOAD
        __syncthreads();
    }
    float hv[16];
#define HK_LOAD(hkp_, ord_, t_) do { const float* hf_ = (hkp_) + (size_t)(ord_) * SEQ; const float* hb_ = (hkp_) + (size_t)(2 + (ord_)) * SEQ; \
        _Pragma("unroll") for (int n1 = 0; n1 < 16; ++n1) { const int n_ = n1 * 512 + (t_); hv[n1] = n1 < 8 ? hf_[n_] : hb_[2 * SEQ - 1 - n_]; } } while (0)
    HK_LOAD(hts, 0, tid);
    int kidx = 0;
    for (int ch = blockIdx.x; ch < D; ch += gridDim.x, ++kidx) {
        const float* hk = hts + (size_t)kidx * (4 * SEQ);
        __syncthreads();
        if (need_ctx && tid < 256) fwc[tid] = fwout[(size_t)(tid & 63) * (4 * D) + (tid >> 6) * D + ch];
        const float delta = fabsf(HY_DMIN + (HY_DMAX - HY_DMIN) * (float)ch / (float)(D - 1));
        const float skip1 = c.in[19][((size_t)jl * 2 + 0) * D + ch], skip2 = c.in[19][((size_t)jl * 2 + 1) * D + ch];
        float tw[3][3];
#pragma unroll
        for (int s = 0; s < 3; ++s)
#pragma unroll
            for (int k = 0; k < 3; ++k) tw[s][k] = cw[(size_t)k * HY_N + s * D + ch];
#pragma unroll 1
        for (int order = 0; order < 2; ++order) {
            const int tq = tidx();
            cpx H[16];
            {   cpx v[16]; float sa = 0.f;
#pragma unroll
                for (int n1 = 0; n1 < 16; ++n1) { const float f = (n1 == 8 && tq == 0) ? 0.f : hv[n1];
                    sa += fabsf(f); v[n1] = {f, 0.f}; }
                sa = block_sum_lds(sa, red);
                const float sc = 1.0f / (sa * 8192.0f);
#pragma unroll
                for (int n1 = 0; n1 < 16; ++n1) v[n1].re *= sc;
                fft_filter(v, A, H); }
            const float skip = order ? skip2 : skip1;
            const float gw0 = order ? tw[2][0] : tw[1][0], gw1 = order ? tw[2][1] : tw[1][1], gw2 = order ? tw[2][2] : tw[1][2];
            const bf16_t* rb = UT + (size_t)ch * TT;
            cpx v0[16], v1[16];
            if (order == 0) {
#pragma unroll
                for (int n1 = 0; n1 < 8; ++n1) { const int pos = n1 * 512 + tq;
                    v0[n1] = {conv3_wave(rb, pos, tw[0][0], tw[0][1], tw[0][2]), conv3_wave(rb + SEQ, pos, tw[0][0], tw[0][1], tw[0][2])};
                    v1[n1] = {conv3_wave(rb + 2 * SEQ, pos, tw[0][0], tw[0][1], tw[0][2]), conv3_wave(rb + 3 * SEQ, pos, tw[0][0], tw[0][1], tw[0][2])};
                    scr[(4 * n1) * 512 + tq] = v0[n1].re; scr[(4 * n1 + 1) * 512 + tq] = v0[n1].im; scr[(4 * n1 + 2) * 512 + tq] = v1[n1].re; scr[(4 * n1 + 3) * 512 + tq] = v1[n1].im; }
            } else {
#pragma unroll
                for (int n1 = 0; n1 < 8; ++n1) { v0[n1] = {scr[(4 * n1) * 512 + tq], scr[(4 * n1 + 1) * 512 + tq]}; v1[n1] = {scr[(4 * n1 + 2) * 512 + tq], scr[(4 * n1 + 3) * 512 + tq]}; }
            }
#pragma unroll
            for (int n1 = 8; n1 < 16; ++n1) { v0[n1] = {0.f, 0.f}; v1[n1] = {0.f, 0.f}; }
            fft2_conv(v0, v1, A, B, H);
            const int te = tidx();
            const bf16_t* gb = UT + (size_t)((order + 1) * D + ch) * TT;
            {   const bool lastc = ch + (int)gridDim.x >= D; const float* hkn = (order == 0 || lastc) ? hk : hk + 4 * SEQ; const int on = (order == 0) ? 1 : (lastc ? 1 : 0);
                HK_LOAD(hkn, on, te); }
#pragma unroll
            for (int hh = 0; hh < 2; ++hh) { float u[4][4]; bf16_t gr[4][4];
#pragma unroll
                for (int q = 0; q < 4; ++q) { const int n1 = hh * 4 + q, pos = n1 * 512 + te;
#pragma unroll
                    for (int b = 0; b < 4; ++b) { u[q][b] = scr[(4 * n1 + b) * 512 + te];
                        gr[q][b] = gb[(size_t)b * SEQ + pos]; } }
                MEM_FENCE();
#pragma unroll
                for (int q = 0; q < 4; ++q) { const int n1 = hh * 4 + q;
                    const float cv[4] = {v0[n1].re, v0[n1].im, v1[n1].re, v1[n1].im};
#pragma unroll
                    for (int b = 0; b < 4; ++b) { const float g1 = bf2f(gr[q][b]); u[q][b] = (gw0 * lane_prev(g1) + gw1 * g1 + gw2 * lane_next(g1)) * (cv[b] + skip * u[q][b]); } }
                if (order == 0) {
#pragma unroll
                    for (int q = 0; q < 4; ++q)
#pragma unroll
                        for (int b = 0; b < 4; ++b) scr[(4 * (hh * 4 + q) + b) * 512 + te] = u[q][b];
                } else {
#pragma unroll
                    for (int q = 0; q < 4; ++q)
#pragma unroll
                        for (int b = 0; b < 4; ++b) Z2[(size_t)ch * TT + (size_t)b * SEQ + (hh * 4 + q) * 512 + te] = f2bf(u[q][b]);
                }
                MEM_FENCE(); }
        }
        if (need_ctx) {
            float* gs = (float*)lds;
            float* uv = gs + 2 * 544;
            float* ux1 = uv + 1024;
            float* ux2 = ux1 + 1024;
            float* zz = ux2 + 1024;
            float* hq = zz + 1024;
            float* part = hq + 1024;
            __syncthreads();
            {   const int p = tid & 255, qh = tid >> 8; const float* hr = c.HID2C(jl) + (size_t)p * 64; float a0 = 0.f, a1 = 0.f;
                f32x4 hv[16];
#pragma unroll
                for (int j = 0; j < 16; ++j) hv[j] = *(const f32x4*)(hr + 4 * j);
#pragma unroll
                for (int j = 0; j < 16; ++j) { const f32x4 fa = *(const f32x4*)(fwc + (2 * qh) * 64 + 4 * j), fb = *(const f32x4*)(fwc + (2 * qh + 1) * 64 + 4 * j);
#pragma unroll
                    for (int e = 0; e < 4; ++e) { a0 += hv[j][e] * fa[e]; a1 += hv[j][e] * fb[e]; } }
                const float dec = expf(-((float)p / (float)(CL - 1)) * delta);
                hq[(2 * qh) * 256 + p] = a0 * dec; hq[(2 * qh + 1) * 256 + p] = a1 * dec; }
            {   bf16_t raw[2][3][3];
#pragma unroll
                for (int k = 0; k < 2; ++k) { const int i = tid + k * NTHREADS, b = i >> 8, p = i & 255; const int pl = p > 0 ? p - 1 : p, pr = p < 255 ? p + 1 : p;
#pragma unroll
                    for (int s3 = 0; s3 < 3; ++s3) { const bf16_t* r = UT + (size_t)(s3 * D + ch) * TT + T + b * CL; raw[k][s3][0] = r[pl]; raw[k][s3][1] = r[p]; raw[k][s3][2] = r[pr]; } }
#pragma unroll
                for (int k = 0; k < 2; ++k) { const int i = tid + k * NTHREADS, p = i & 255; float o[3];
#pragma unroll
                    for (int s3 = 0; s3 < 3; ++s3) o[s3] = tw[s3][0] * (p > 0 ? bf2f(raw[k][s3][0]) : 0.f) + tw[s3][1] * bf2f(raw[k][s3][1]) + tw[s3][2] * (p < 255 ? bf2f(raw[k][s3][2]) : 0.f);
                    uv[i] = o[0]; ux1[i] = o[1]; ux2[i] = o[2]; } }
            __syncthreads();
            float s0 = 0.f, s1 = 0.f;
            if (tid < 256) { s0 = fabsf(hq[tid]) + (tid < 255 ? fabsf(hq[512 + tid]) : 0.f); s1 = fabsf(hq[256 + tid]) + (tid < 255 ? fabsf(hq[768 + tid]) : 0.f); }
            s0 = block_sum(s0, red); s1 = block_sum(s1, red);
            for (int i = tid; i < 2 * 544; i += NTHREADS) { const int order = i / 544, m = i % 544, n = (m + 249) & 511; float f;
                if (n < 256) f = hq[order * 256 + n]; else if (n == 256) f = 0.f; else f = hq[(2 + order) * 256 + (511 - n)];
                gs[i] = f / (order ? s1 : s0); }
            __syncthreads();
            const int og = tid & 127, sg = tid >> 7, cb = og >> 5, t0 = (og & 31) * 8;
#pragma unroll 1
            for (int order = 0; order < 2; ++order) {
                const float* src = (order ? zz : uv) + cb * 256; const float* gp = gs + order * 544;
                float acc[8];
#pragma unroll
                for (int j = 0; j < 8; ++j) acc[j] = 0.f;
#pragma unroll 2
                for (int s8 = 0; s8 < 8; ++s8) { const int sb = 64 * sg + 8 * s8;
                    const f32x4* wq = (const f32x4*)(gp + t0 - sb + 256); const f32x4 w0 = wq[0], w1 = wq[1], w2 = wq[2], w3 = wq[3];
                    const f32x4 ua = *(const f32x4*)(src + sb), ub = *(const f32x4*)(src + sb + 4);
                    const float W[16] = {w0[0], w0[1], w0[2], w0[3], w1[0], w1[1], w1[2], w1[3], w2[0], w2[1], w2[2], w2[3], w3[0], w3[1], w3[2], w3[3]};
                    const float U[8] = {ua[0], ua[1], ua[2], ua[3], ub[0], ub[1], ub[2], ub[3]};
#pragma unroll
                    for (int u = 0; u < 8; ++u)
#pragma unroll
                        for (int j = 0; j < 8; ++j) acc[j] += W[7 + j - u] * U[u]; }
                *(f32x4*)(part + (sg * 128 + og) * 8) = (f32x4){acc[0], acc[1], acc[2], acc[3]}; *(f32x4*)(part + (sg * 128 + og) * 8 + 4) = (f32x4){acc[4], acc[5], acc[6], acc[7]};
                __syncthreads();
                for (int i = tid; i < 1024; i += NTHREADS) { const int g2 = i >> 3, j = i & 7;
                    const float y = (part[g2 * 8 + j] + part[(128 + g2) * 8 + j]) + (part[(256 + g2) * 8 + j] + part[(384 + g2) * 8 + j]);
                    if (order == 0) zz[i] = ux1[i] * (y + skip1 * uv[i]);
                    else Z2[(size_t)ch * TT + T + (i >> 8) * CL + (i & 255)] = f2bf(ux2[i] * (y + skip2 * zz[i])); }
                __syncthreads();
            }
        }
    }
}

#undef HK_LOAD
#ifndef HOST_EMU
struct Args { const float* in[30]; float* out; unsigned char* ws; int ph_lo, ph_hi; };
constexpr int PH_PER_LAYER = 9;
constexpr int N_PHASES = 2 + PH_PER_LAYER * DEPTH;

__global__ void __launch_bounds__(NTHREADS, 2) fwd_kernel(Args args) {
    extern __shared__ __attribute__((aligned(16))) unsigned char lds[];
    Ctx c;
#pragma unroll
    for (int i = 0; i < 30; ++i) c.in[i] = args.in[i];
    c.out = args.out; c.ws = args.ws;
    const int lo = args.ph_lo, hi = args.ph_hi;
    volatile LAS unsigned* bst = (volatile LAS unsigned*)((LAS unsigned char*)lds + LDS_BAR_OFF);
    XcdBarrier bar; bar.bar = (unsigned*)(args.ws + WS_CTL); bar.x = 0; bar.st = bst;
    if (!MK_PER_PHASE) {
        if (threadIdx.x == 0) { bst[0] = 0u; bst[1] = 0u; bst[2] = 0u; bst[3] = 0u; }
        __syncthreads();
        bar = xcd_barrier_post((unsigned*)(args.ws + WS_CTL), bst);
    }
#define IN(k) (lo <= (k) && (k) < hi)
#define SEAM(k) do { if (IN(k) && IN((k) + 1)) xcd_barrier(bar); } while (0)
    LAS unsigned char* glds = (LAS unsigned char*)lds;
    const int G = (int)gridDim.x, bid = (int)blockIdx.x;

    if (DBG(0) && IN(0)) { _Pragma("unroll 1") for (int rep_ = 0; rep_ < REPS(0); ++rep_) prologue_phase(c, lds); }
    SEAM(0);
#pragma unroll 1
    for (int l = 0; l < DEPTH; ++l) {
        const int base = 1 + PH_PER_LAYER * l, kind = l % 3, j = l / 3;
        const bool last = (l == DEPTH - 1);
        const bool need_ctx = !last || kind != 0;
        const int rows = need_ctx ? TT : T;
        float* modv = c.MODV(l);
        const bool ctx_ffn = l < 2;
        float* P1 = c.O2();
        float* P2 = c.O2() + (size_t)8 * TC * D;
        if (DBG(1) && IN(base + 0)) {
            const float* pg_ = c.MODV(l > 0 ? l - 1 : 0) + (size_t)NBATCH * NMOD * D + 5 * D;
            if (l == 0) norm_mod_phase<true, true>(c.in[0], c.in[2], c.X() + (size_t)T * D, c.in[6] + (size_t)l * D, modv, 0, 1, c.HN(), rows, P2, 0, pg_);
            else norm_mod_phase<false, false>(c.X(), c.X() + (size_t)T * D, c.X() + (size_t)T * D, c.in[6] + (size_t)l * D, modv, 0, 1, c.HN(), rows, P2, (l == 1 || l == 2) ? 4 : 0, pg_); }
        SEAM(base + 0);
        if (IN(base + 1)) _Pragma("unroll 1") for (int rep_ = 0; rep_ < REPS(2); ++rep_) {
            if (DBG(2) && kind == 0) {
                pg8::Gemm g{(const bf16_t*)(c.ws + WS_WHYIN) + (size_t)j * HY_N * D, c.HN(), HY_N, rows, D, D}; pg8::StaticOrder S; S.init(HY_N, rows, G, bid);
                EpiStoreBf16 E{c.U(), TT};
                pg8::gemm_phase<EpiStoreBf16, pg8::StaticOrder>(glds, g, S, E);
            } else if (DBG(3) && kind == 1) {
                pg8::Gemm g{c.HN(), (const bf16_t*)(c.ws + WS_WHGIN), rows, HG_N, D, D}; pg8::StaticOrder S; S.init(rows, HG_N, G, bid);
                EpiHgIn E{c.U(), c.LB()};
                pg8::gemm_phase<EpiHgIn, pg8::StaticOrder>(glds, g, S, E);
            } else if (DBG(4) && kind == 2) {
                pg8::Gemm g{c.HN(), (const bf16_t*)(c.ws + WS_WGLIN), rows, GLA_NP, D, D}; pg8::StaticOrder S; S.init(rows, GLA_NP, G, bid);
                EpiGlaIn E{c.U(), c.GA()};
                pg8::gemm_phase<EpiGlaIn, pg8::StaticOrder>(glds, g, S, E);
            }
        }
        SEAM(base + 1);
        if (IN(base + 2)) {
            if (DBG(5) && kind == 0) _Pragma("unroll 1") for (int rep_ = 0; rep_ < REPS(3); ++rep_) hyena_conv_phase(c, j, need_ctx, lds);
            else if (DBG(6) && kind == 1) _Pragma("unroll 1") for (int rep_ = 0; rep_ < REPS(4); ++rep_) scan_prep_phase<128, 128, 16, false>(c, lds);
            else if (DBG(7) && kind == 2) _Pragma("unroll 1") for (int rep_ = 0; rep_ < REPS(4); ++rep_) scan_prep_phase<256, 512, 4, true>(c, lds);
        }
        SEAM(base + 2);
        if (IN(base + 3)) {
            if (DBG(13) && kind == 1) scan_seq_phase<128, 128, 16>(c, lds);
            else if (DBG(14) && kind == 2) scan_seq_phase<256, 512, 4>(c, lds);
        }
        if (kind != 0) SEAM(base + 3);
        if (IN(base + 4)) _Pragma("unroll 1") for (int rep_ = 0; rep_ < REPS(1); ++rep_) {
            if (DBG(8) && kind == 0) transpose_z_phase(c.Z2T(), c.HN(), rows, lds);
            else if (DBG(8) && kind == 1) headnorm_phase<128>(c.O4(), c.in[23] + (size_t)j * D, c.U(), HG_N, 4096, c.HN(), rows);
            else if (DBG(8) && kind == 2) headnorm_phase<512>(c.O4(), c.in[28] + (size_t)j * D, c.U(), GLA_NV, 4096, c.HN(), rows);
        }
        SEAM(base + 4);
        if (DBG(9) && IN(base + 5)) {
            const bf16_t* wt = kind == 0 ? (const bf16_t*)(c.ws + WS_WHYOUT) + (size_t)j * D * D : (kind == 1 ? (const bf16_t*)(c.ws + WS_WHGOUT) : (const bf16_t*)(c.ws + WS_WGLOUT));
            {   pg8::Gemm g{c.HN(), wt, T, D, D, D}; pg8::StaticOrder S; S.init(T, D, G, bid);
                if (l == 0) { EpiResid<true> E{c.in[0], c.X(), modv + 2 * D};
                    pg8::gemm_phase<EpiResid<true>, pg8::StaticOrder>(glds, g, S, E); }
                else { EpiResid<false> E{c.X(), c.X(), modv + 2 * D};
                    pg8::gemm_phase<EpiResid<false>, pg8::StaticOrder>(glds, g, S, E); } }
            if (ctx_ffn) {
                pg8::Gemm g{c.HN() + (size_t)T * D, wt, TC, D, D / 8, D}; pg8::SplitKOrder S; S.init(TC, D, 8, G, bid);
                EpiPartial E{P1};
                pg8::gemm_phase<EpiPartial, pg8::SplitKOrder>(glds, g, S, E); }
        }
        SEAM(base + 5);
        const int frows = ctx_ffn ? TT : T;
        if (DBG(1) && IN(base + 6)) {
            if (l == 0) norm_mod_phase<false, true>(c.X(), c.in[2], c.X() + (size_t)T * D, c.in[7] + (size_t)l * D, modv, 3, 4, c.HN(), frows, P1, ctx_ffn ? 8 : 0, modv + (size_t)NBATCH * NMOD * D + 2 * D);
            else norm_mod_phase<false, false>(c.X(), c.X() + (size_t)T * D, c.X() + (size_t)T * D, c.in[7] + (size_t)l * D, modv, 3, 4, c.HN(), frows, P1, ctx_ffn ? 8 : 0, modv + (size_t)NBATCH * NMOD * D + 2 * D); }
        SEAM(base + 6);
        if (DBG(10) && IN(base + 7)) _Pragma("unroll 1") for (int rep_ = 0; rep_ < REPS(6); ++rep_) {
            pg8::Gemm g{c.HN(), (const bf16_t*)(c.ws + WS_WFIN) + (size_t)l * 2 * FF * D, frows, 2 * FF, D, D}; pg8::StaticOrder S; S.init(frows, 2 * FF, G, bid);
            EpiSwiGLU E{c.U()};
            pg8::gemm_phase<EpiSwiGLU, pg8::StaticOrder>(glds, g, S, E);
        }
        SEAM(base + 7);
        if (DBG(11) && IN(base + 8)) {
            const bf16_t* wt = (const bf16_t*)(c.ws + WS_WFOUT) + (size_t)l * D * FF;
            {   pg8::Gemm g{c.U(), wt, T, D, FF, FF}; pg8::StaticOrder S; S.init(T, D, G, bid);
                EpiResid<false> E{c.X(), c.X(), modv + 5 * D};
                pg8::gemm_phase<EpiResid<false>, pg8::StaticOrder>(glds, g, S, E); }
            if (ctx_ffn) {
                pg8::Gemm g{c.U() + (size_t)T * FF, wt, TC, D, FF / 4, FF}; pg8::SplitKOrder S; S.init(TC, D, 4, G, bid);
                EpiPartial E{P2};
                pg8::gemm_phase<EpiPartial, pg8::SplitKOrder>(glds, g, S, E); }
        }
        SEAM(base + 8);
    }
    if (DBG(12) && IN(N_PHASES - 1)) final_norm_phase(c.X(), c.in[10], c.out, T);
#undef IN
#undef SEAM
}

extern "C" void kernel_launch(void* const* d_in, const int* in_sizes, int n_in, void* d_out, int out_size, void* d_ws, size_t ws_size, hipStream_t stream) {
    static int grid = 0;
    if (grid == 0) {
        if (n_in != 30 || out_size != T * D || ws_size < WS_END) { fprintf(stderr, "kernel_launch: unexpected shapes (n_in %d out %d ws %zu need %zu)\n", n_in, out_size, ws_size, (size_t)WS_END); grid = -1; return; }
        int dev = 0, cus = 0, per_cu = 0;
        if (hipGetDevice(&dev) != hipSuccess || hipDeviceGetAttribute(&cus, hipDeviceAttributeMultiprocessorCount, dev) != hipSuccess) { grid = -1; return; }
        if (hipFuncSetAttribute((const void*)fwd_kernel, hipFuncAttributeMaxDynamicSharedMemorySize, LDS_BYTES) != hipSuccess) { fprintf(stderr, "kernel_launch: hipFuncSetAttribute failed\n"); grid = -1; return; }
        if (hipOccupancyMaxActiveBlocksPerMultiprocessor(&per_cu, (const void*)fwd_kernel, NTHREADS, LDS_BYTES) != hipSuccess || per_cu < 1) fprintf(stderr, "kernel_launch: occupancy query reports %d\n", per_cu);
        (void)hipGetLastError();
        grid = cus;
    }
    if (grid < 0) return;
    (void)in_sizes;
    if (hipMemsetAsync((char*)d_ws + WS_CTL, 0, CTL_BYTES, stream) != hipSuccess) return;
    Args a{};
    for (int i = 0; i < 30; ++i) a.in[i] = (const float*)d_in[i];
    a.out = (float*)d_out; a.ws = (unsigned char*)d_ws;
#if MK_PER_PHASE
    for (int p = 0; p < N_PHASES; ++p) { a.ph_lo = p; a.ph_hi = p + 1; hipLaunchKernelGGL(fwd_kernel, dim3(grid), dim3(NTHREADS), LDS_BYTES, stream, a); }
#else
    a.ph_lo = 0; a.ph_hi = N_PHASES;
    hipLaunchKernelGGL(fwd_kernel, dim3(grid), dim3(NTHREADS), LDS_BYTES, stream, a);
#endif
}
#endif
```

```cpp
#ifdef HOST_EMU
#include "emu.h"
#else
#include <hip/hip_runtime.h>
#include <cstdio>
#endif

#ifndef MK_PER_PHASE
#define MK_PER_PHASE 0
#endif

#ifndef DBG_ONLY
#define DBG_ONLY (-1)
#endif
#ifndef DBG_MASK
#define DBG_MASK 0
#endif
#define DBG(n) (DBG_ONLY < 0 || DBG_ONLY == (n) || ((DBG_MASK >> (n)) & 1))
#ifndef PROBE_MASK
#define PROBE_MASK 0
#endif
#define REPS(b) (((PROBE_MASK >> (b)) & 1) ? 2 : 1)
#define DI __device__ __forceinline__
typedef unsigned short bf16_t;
typedef short bf16x8 __attribute__((ext_vector_type(8)));
typedef float f32x4 __attribute__((ext_vector_type(4)));
typedef unsigned u32x4 __attribute__((ext_vector_type(4)));
typedef unsigned u32x2 __attribute__((ext_vector_type(2)));
typedef unsigned short u16x4 __attribute__((ext_vector_type(4)));

constexpr int D = 2048, NBATCH = 4, SEQ = 4096, T = NBATCH * SEQ, CL = 256, TC = NBATCH * CL, TT = T + TC;
constexpr int NMOD = 6, FF = 5632, DEPTH = 4, NTHREADS = 512;
constexpr float RMS_EPS = 1e-6f;
constexpr int HG_N = 5 * D;
constexpr int GLA_NV = 6144;
constexpr int GLA_N = 6176, GLA_NP = 6400;
constexpr int HY_N = 3 * D;

constexpr size_t al256(size_t x) { return (x + 255) & ~(size_t)255; }
constexpr size_t WS_CTL = 0, CTL_BYTES = 1u << 20;
constexpr size_t WS_MODV = WS_CTL + CTL_BYTES;
constexpr size_t WS_LB = WS_MODV + al256((size_t)DEPTH * 5 * NMOD * D * 4);
constexpr size_t WS_HID2L = WS_LB + al256(2 * D * 4);
constexpr size_t WS_HID2C = WS_HID2L + (size_t)2 * SEQ * 64 * 4;
constexpr size_t WS_WHYIN = WS_HID2C + (size_t)2 * CL * 64 * 4;
constexpr size_t WS_WHYOUT = WS_WHYIN + (size_t)2 * HY_N * D * 2;
constexpr size_t WS_WHGIN = WS_WHYOUT + (size_t)2 * D * D * 2;
constexpr size_t WS_WHGOUT = WS_WHGIN + (size_t)HG_N * D * 2;
constexpr size_t WS_WGLIN = WS_WHGOUT + (size_t)D * D * 2;
constexpr size_t WS_WGLOUT = WS_WGLIN + (size_t)GLA_NP * D * 2;
constexpr size_t WS_WFIN = WS_WGLOUT + (size_t)D * D * 2;
constexpr size_t WS_WFOUT = WS_WFIN + (size_t)DEPTH * 2 * FF * D * 2;
constexpr size_t WS_X = WS_WFOUT + (size_t)DEPTH * D * FF * 2;
constexpr size_t WS_U = WS_X + (size_t)TT * D * 4;
constexpr size_t WS_O2 = WS_U + (size_t)TT * HG_N * 2;
constexpr size_t WS_HTS = WS_O2 + (size_t)D * TT * 2;
constexpr size_t WS_GA = WS_O2 + (size_t)2 * TT * D * 4;
constexpr size_t WS_HN = WS_GA + (size_t)TT * 32 * 4;
constexpr size_t WS_TAIL = WS_HN + (size_t)TT * D * 2;
constexpr size_t WS_HYS = WS_TAIL;
constexpr size_t HYS_PER_BLOCK = (size_t)32 * 512 * 4;
constexpr size_t WS_PQT = WS_HN;
constexpr size_t WS_PKT = WS_PQT + (size_t)2 * TT * D * 2;
constexpr size_t WS_PVT = WS_PKT + (size_t)2 * TT * D * 2;
constexpr size_t WS_PEM = WS_PVT + (size_t)TT * D * 2;
constexpr size_t WS_END = WS_PEM + (size_t)2 * 4 * 16 * 68 * 2 * 128 * 4;
static_assert(WS_HYS + 256 * HYS_PER_BLOCK <= WS_END, "hyena scratch");
static_assert(WS_HTS + (size_t)256 * 8 * 4 * SEQ * 4 <= WS_GA, "hyena filter scratch");
static_assert(WS_END <= (size_t)1610612736, "workspace budget (4 x largest input)");

constexpr int LDS_BYTES = 163840;
constexpr int LDS_BAR_OFF = LDS_BYTES - 16;

#ifdef HOST_EMU
static inline unsigned f_as_u(float f) { unsigned u; memcpy(&u, &f, 4); return u; }
static inline float u_as_f(unsigned u) { float f; memcpy(&f, &u, 4); return f; }
static inline float sin_rev(float x) { return (float)sin(6.283185307179586 * (double)x); }
static inline float cos_rev(float x) { return (float)cos(6.283185307179586 * (double)x); }
static inline f32x4 mma16(bf16x8 x, bf16x8 y, f32x4 c) { return emu_mfma_16x16x32(x, y, c); }
static inline float shfl_xor_f(float v, int m) { return emu_shfl_xor(v, m); }
static inline float fast_rcp(float x) { return 1.0f / x; }
static inline float pin_f(float x) { return x; }
static inline float lane_xor1(float v) { return emu_shfl_xor(v, 1); }
static inline float lane_prev(float v) { const float r = emu_shfl(v, (emu::S.cur & 63) - 1); return (emu::S.cur & 63) == 0 ? 0.f : r; }
static inline float lane_next(float v) { const float r = emu_shfl(v, (emu::S.cur & 63) + 1); return (emu::S.cur & 63) == 63 ? 0.f : r; }
#define PIN_ACC(a) do { } while (0)
#define PIN4(a, b, c, d) do { } while (0)
#define PIN12(a) do { } while (0)
#define MEM_FENCE() do { } while (0)
static inline void lds_barrier() { emu::block_barrier(); }
static inline float fexp2(float x) { return exp2f(x); }
static inline float flog2(float x) { return log2f(x); }
static inline int tidx() { return (int)threadIdx.x; }
static inline void atomic_add_f32(float* p, float v) { *p += v; }
#else
DI unsigned f_as_u(float f) { return __float_as_uint(f); }
DI float u_as_f(unsigned u) { return __uint_as_float(u); }
DI float sin_rev(float x) { return __builtin_amdgcn_sinf(x); }
DI float cos_rev(float x) { return __builtin_amdgcn_cosf(x); }
DI f32x4 mma16(bf16x8 x, bf16x8 y, f32x4 c) { return __builtin_amdgcn_mfma_f32_16x16x32_bf16(x, y, c, 0, 0, 0); }
DI float shfl_xor_f(float v, int m) { return __shfl_xor(v, m); }
DI float fast_rcp(float x) { return __builtin_amdgcn_rcpf(x); }
DI float pin_f(float x) { asm volatile("" : "+v"(x)); return x; }
#define PIN_ACC(a) asm volatile("" : "+v"(a))
#define PIN4(a, b, c, d) asm volatile("" : "+v"(a), "+v"(b), "+v"(c), "+v"(d))
#define PIN12(a) asm volatile("" : "+v"(a[0]), "+v"(a[1]), "+v"(a[2]), "+v"(a[3]), "+v"(a[4]), "+v"(a[5]), "+v"(a[6]), "+v"(a[7]), "+v"(a[8]), "+v"(a[9]), "+v"(a[10]), "+v"(a[11]))
#define MEM_FENCE() asm volatile("" ::: "memory")
DI void lds_barrier() { asm volatile("s_waitcnt lgkmcnt(0)\n\ts_barrier" ::: "memory"); }
DI float lane_xor1(float v) { return __builtin_bit_cast(float, __builtin_amdgcn_update_dpp(0, __builtin_bit_cast(int, v), 0xB1, 0xf, 0xf, true)); }
DI float lane_prev(float v) { return __builtin_bit_cast(float, __builtin_amdgcn_update_dpp(0, __builtin_bit_cast(int, v), 0x138, 0xf, 0xf, true)); }
DI float lane_next(float v) { return __builtin_bit_cast(float, __builtin_amdgcn_update_dpp(0, __builtin_bit_cast(int, v), 0x130, 0xf, 0xf, true)); }
DI float fexp2(float x) { return __builtin_amdgcn_exp2f(x); }
DI float flog2(float x) { return __builtin_amdgcn_logf(x); }
DI void atomic_add_f32(float* p, float v) { (void)__hip_atomic_fetch_add(p, v, __ATOMIC_RELAXED, __HIP_MEMORY_SCOPE_AGENT); }
DI int tidx() { int t = (int)threadIdx.x; asm volatile("" : "+v"(t)); return t; }
#endif
#ifdef HOST_EMU
DI bf16_t f2bf(float f) { unsigned u = f_as_u(f); u += 0x7fffu + ((u >> 16) & 1u); return (bf16_t)(u >> 16); }
DI unsigned pack_bf2(float lo, float hi) { return (unsigned)f2bf(lo) | ((unsigned)f2bf(hi) << 16); }
#else
typedef float f32x2_t __attribute__((ext_vector_type(2)));
typedef __bf16 bf16x2_t __attribute__((ext_vector_type(2)));
DI unsigned pack_bf2(float lo, float hi) { const bf16x2_t r = __builtin_convertvector((f32x2_t){lo, hi}, bf16x2_t); return __builtin_bit_cast(unsigned, r); }
DI bf16_t f2bf(float f) { return (bf16_t)(pack_bf2(f, f) & 0xffffu); }
#endif
DI float bf2f(bf16_t b) { return u_as_f(((unsigned)b) << 16); }
DI float silu_f(float x) { return x / (1.0f + expf(-x)); }
DI float silu_fast(float x) { return x * fast_rcp(1.0f + fexp2(-1.4426950408889634f * x)); }
DI float wave_sum(float v) { v += shfl_xor_f(v, 32); v += shfl_xor_f(v, 16); v += shfl_xor_f(v, 8); v += shfl_xor_f(v, 4); v += shfl_xor_f(v, 2); v += shfl_xor_f(v, 1); return v; }
DI int mod_index(int row) { return row < T ? row / SEQ : NBATCH; }

#ifndef HOST_EMU
#define XB_TMO      128
#define XB_XCNT(j)  (256  + 64 * (j))
#define XB_XSUB(j)  (1280 + 64 * (j))
#define XB_XGEN(j)  (2304 + 64 * (j))
#define XB_TOP      3328
#define XB_TOPGEN   3392
#define XCD_BAR_WORDS 3456
#define XB_SPIN_CAP (1u << 22)
#define LAS __attribute__((address_space(3)))

__device__ __forceinline__ unsigned xb_ld(unsigned* p)              { return __hip_atomic_load(p, __ATOMIC_RELAXED, __HIP_MEMORY_SCOPE_AGENT); }
__device__ __forceinline__ unsigned xb_add(unsigned* p, unsigned v) { return __hip_atomic_fetch_add(p, v, __ATOMIC_RELAXED, __HIP_MEMORY_SCOPE_AGENT); }
__device__ __forceinline__ unsigned xb_xcc_id() { return (unsigned)__builtin_amdgcn_s_getreg((3 << 11) | 20) & 0xFu; }
#define XB_SPIN(cond, bar) do { unsigned _sp = 0; while (cond) { __builtin_amdgcn_s_sleep(1); \
    if ((++_sp & 255u) == 0u) { if (xb_ld(&(bar)[XB_TMO])) break; if (_sp > XB_SPIN_CAP) { atomicAdd(&(bar)[XB_TMO], 1u); break; } } } } while (0)

struct XcdBarrier { unsigned* bar; unsigned x; volatile LAS unsigned* st; };

__device__ __forceinline__ XcdBarrier xcd_barrier_post(unsigned* bar, volatile LAS unsigned* st) {
    XcdBarrier b; b.bar = bar; b.x = xb_xcc_id(); b.st = st;
    if (threadIdx.x == 0) (void)xb_add(&bar[XB_XCNT(b.x)], 1u);
    return b;
}
__device__ __forceinline__ void xcd_barrier_complete(unsigned* bar, unsigned x, unsigned& nloc, unsigned& nx) {
    const unsigned G = gridDim.x * gridDim.y * gridDim.z;
    unsigned sum, cnt, mine, sp = 0u;
    for (;;) {
        sum = 0u; cnt = 0u; mine = 0u;
#pragma unroll
        for (unsigned j = 0; j < 16; ++j) { const unsigned c = xb_ld(&bar[XB_XCNT(j)]); sum += c; cnt += (c > 0u) ? 1u : 0u; mine = (j == x) ? c : mine; }
        if (sum == G) break;
        __builtin_amdgcn_s_sleep(1);
        if ((++sp & 255u) == 0u) { if (xb_ld(&bar[XB_TMO])) break; if (sp > XB_SPIN_CAP) { atomicAdd(&bar[XB_TMO], 1u); break; } }
    }
    nloc = mine > 0u ? mine : 1u; nx = cnt > 0u ? cnt : 1u;
}
__device__ __forceinline__ void xcd_barrier(const XcdBarrier& b) {
    asm volatile("s_waitcnt vmcnt(0)" ::: "memory");
    __syncthreads();
    if (threadIdx.x == 0) {
        unsigned* bar = b.bar;
        __builtin_amdgcn_s_waitcnt(0);
        unsigned nloc = b.st[0], nx = b.st[1];
        if (nloc == 0u) { xcd_barrier_complete(bar, b.x, nloc, nx); b.st[0] = nloc; b.st[1] = nx; }
        const unsigned old = xb_add(&bar[XB_XSUB(b.x)], 1u);
        const unsigned gen = old / nloc;
        if (old + 1u == (gen + 1u) * nloc) {
            __builtin_amdgcn_fence(__ATOMIC_RELEASE, "agent");
            asm volatile("s_waitcnt vmcnt(0)" ::: "memory");
            const unsigned og = xb_add(&bar[XB_TOP], 1u);
            const unsigned tg = og / nx;
            if (og + 1u == (tg + 1u) * nx) xb_add(&bar[XB_TOPGEN], 1u);
            else XB_SPIN(xb_ld(&bar[XB_TOPGEN]) == tg, bar);
            __builtin_amdgcn_fence(__ATOMIC_ACQUIRE, "agent");
            xb_add(&bar[XB_XGEN(b.x)], 1u);
            asm volatile("s_waitcnt vmcnt(0)" ::: "memory");
        } else {
            XB_SPIN(xb_ld(&bar[XB_XGEN(b.x)]) == gen, bar);
            __builtin_amdgcn_fence(__ATOMIC_ACQUIRE, "agent");
            asm volatile("s_waitcnt vmcnt(0)" ::: "memory");
        }
    }
    __syncthreads();
}
#endif

namespace pg8 {
constexpr int BM = 256, BK = 64, HALF = 128, HTB = HALF * BK * 2, STAGE_BYTES = 8 * HTB, NXCD = 8, WGM = 4;
struct Unit { int pm, pn, pk; };
struct Gemm { const bf16_t* A; const bf16_t* Bt; int M, N, K, ld; };
struct StaticOrder {
    int nM, nN, nwg, G, c;
    __host__ __device__ void init(int M, int N, int G_, int c_) { nM = M / BM; nN = N / BM; nwg = nM * nN; G = G_; c = c_; }
    __host__ __device__ bool next(int i, Unit& u) const {
        const long L = (long)i * G + c; if (L >= nwg) return false;
        int wgid = (int)L; { const int q = nwg / NXCD, r = nwg % NXCD, xcd = wgid % NXCD, off = wgid / NXCD; wgid = (xcd < r ? xcd * (q + 1) : r * (q + 1) + (xcd - r) * q) + off; }
        const int nig = WGM * nN, gid = wgid / nig, fm = gid * WGM, gsz = (nM - fm) < WGM ? (nM - fm) : WGM;
        u.pm = fm + ((wgid % nig) % gsz); u.pn = (wgid % nig) / gsz; u.pk = 0; return true;
    }
    __device__ __forceinline__ void a_ready(const Unit&) const {}
    __device__ __forceinline__ void done(const Unit&) const {}
};
struct SplitKOrder {
    int nM, nN, nK, nwg, G, c;
    __host__ __device__ void init(int M, int N, int nK_, int G_, int c_) { nM = M / BM; nN = N / BM; nK = nK_; nwg = nM * nN * nK; G = G_; c = c_; }
    __host__ __device__ bool next(int i, Unit& u) const { const long L = (long)i * G + c; if (L >= nwg) return false; const int l = (int)L; u.pn = l % nN; u.pm = (l / nN) % nM; u.pk = l / (nN * nM); return true; }
    __device__ __forceinline__ void a_ready(const Unit&) const {}
    __device__ __forceinline__ void done(const Unit&) const {}
};
#ifndef HOST_EMU
#define PG8_LAS __attribute__((address_space(3)))
__host__ __device__ __forceinline__ int lds_byte(int r, int c) { const int st = (r >> 4) * 2 + (c >> 5), rr = r & 15, cc = c & 31, ob = rr * 64 + cc * 2; return st * 1024 + (ob ^ (((ob >> 9) & 1) << 5)); }
__host__ __device__ __forceinline__ void stage_rc(int b, int& R, int& C) { const int st = b / 1024, sb = b % 1024, swz = sb ^ (((sb >> 9) & 1) << 5); R = (st >> 1) * 16 + swz / 64; C = (st & 1) * 32 + (swz % 64) / 2; }
__host__ __device__ __forceinline__ int perm32(int rho) { const int n = rho >> 4, i = rho & 15; return 8 * (i >> 2) + 4 * n + (i & 3); }

template <class Epi, class Sched>
__device__ __forceinline__ void gemm_phase(PG8_LAS unsigned char* lds, const Gemm g, const Sched& S, const Epi& E) {
    const int tid = tidx(), wid = __builtin_amdgcn_readfirstlane(tid >> 6), lane = tid & 63, wr = wid >> 2, wc = wid & 3, fr = lane & 15, fq = lane >> 4;
    const int K = g.ld, nt = g.K / BK;
    const size_t kpart = (size_t)g.K * 2;
    unsigned voffA[2], voffB[2];
#pragma unroll
    for (int i = 0; i < 2; ++i) { int R, C; stage_rc(tid * 16 + i * 8192, R, C); const int Rb = Epi::PERM ? ((R & ~31) + perm32(R & 31)) : R;
        voffA[i] = (unsigned)(R * K + C) * 2u; voffB[i] = (unsigned)(Rb * K + C) * 2u; }
    const size_t kstep = (size_t)(BK * 2);
    const size_t hstep = (size_t)HALF * K * 2;
    const size_t tstep = 2 * hstep;
    const unsigned ldsw = (unsigned)wid * 1024u;
    const int aoff = lds_byte(wr * 64 + fr, fq * 8), boff = lds_byte(wc * 32 + fr, fq * 8);
#define PG8_SA(b, h) (((b) * 2 + (h)) * HTB)
#define PG8_SB(b, h) ((4 + (b) * 2 + (h)) * HTB)
#define PG8_STAGE(bufoff, gbase, voff) do { _Pragma("unroll") for (int _i = 0; _i < 2; ++_i) \
        __builtin_amdgcn_global_load_lds((const unsigned*)((const char*)(gbase) + (voff)[_i]), (PG8_LAS unsigned*)(lds + (bufoff) + ldsw + _i * 8192), 16, 0, 0); } while (0)
#define PG8_LDA(dst, b, h) do { _Pragma("unroll") for (int m = 0; m < 4; ++m) _Pragma("unroll") for (int k = 0; k < 2; ++k) dst[m][k] = *(const PG8_LAS bf16x8*)(lds + PG8_SA(b, h) + aoff + m * 2048 + k * 1024); } while (0)
#define PG8_LDB(dst, b, h) do { _Pragma("unroll") for (int n = 0; n < 2; ++n) _Pragma("unroll") for (int k = 0; k < 2; ++k) dst[n][k] = *(const PG8_LAS bf16x8*)(lds + PG8_SB(b, h) + boff + n * 2048 + k * 1024); } while (0)
#define PG8_MMA(ai, bj, At, Bt) do { __builtin_amdgcn_s_setprio(1); _Pragma("unroll") for (int m = 0; m < 4; ++m) _Pragma("unroll") for (int n = 0; n < 2; ++n) _Pragma("unroll") for (int k = 0; k < 2; ++k) \
        acc[ai][bj][m][n] = __builtin_amdgcn_mfma_f32_16x16x32_bf16(Bt[n][k], At[m][k], acc[ai][bj][m][n], 0, 0, 0); __builtin_amdgcn_s_setprio(0); } while (0)
#define PG8_WAIT_V(n) asm volatile("s_waitcnt vmcnt(" #n ")" ::: "memory")
#define PG8_WAIT_L(n) asm volatile("s_waitcnt lgkmcnt(" #n ")" ::: "memory")
#define PG8_BAR __builtin_amdgcn_s_barrier()
#define PG8_SCHED __builtin_amdgcn_sched_barrier(0)
    Unit cur, nxt; int ui = 0;
    if (!S.next(0, cur)) return;
    f32x4 acc[2][2][4][2];
#pragma unroll
    for (int a = 0; a < 2; ++a)
#pragma unroll
        for (int b = 0; b < 2; ++b)
#pragma unroll
            for (int m = 0; m < 4; ++m)
#pragma unroll
                for (int n = 0; n < 2; ++n) acc[a][b][m][n] = (f32x4){0.f, 0.f, 0.f, 0.f};
    bf16x8 At[4][2], B0[2][2], B1[2][2];
    const char* cA = (const char*)g.A + (size_t)cur.pm * tstep + (size_t)cur.pk * kpart; const char* cB = (const char*)g.Bt + (size_t)cur.pn * tstep + (size_t)cur.pk * kpart;
    S.a_ready(cur);
    PG8_STAGE(PG8_SB(0, 0), cB, voffB); PG8_STAGE(PG8_SA(0, 0), cA, voffA); PG8_STAGE(PG8_SB(0, 1), cB + hstep, voffB); PG8_STAGE(PG8_SA(0, 1), cA + hstep, voffA);
    if (wr == 1) PG8_BAR;
    PG8_WAIT_V(4); PG8_BAR;
    PG8_STAGE(PG8_SB(1, 0), cB + kstep, voffB); PG8_STAGE(PG8_SA(1, 0), cA + kstep, voffA); PG8_STAGE(PG8_SB(1, 1), cB + hstep + kstep, voffB);
    PG8_WAIT_V(6); PG8_BAR;
    for (;;) {
        const bool has_next = S.next(ui + 1, nxt);
        const char* nA = has_next ? (const char*)g.A + (size_t)nxt.pm * tstep + (size_t)nxt.pk * kpart : cA; const char* nB = has_next ? (const char*)g.Bt + (size_t)nxt.pn * tstep + (size_t)nxt.pk * kpart : cB;
        for (int t = 0; t < nt; t += 2) {
            const bool last = (t == nt - 2);
            const char* a1 = cA + (size_t)(t + 1) * kstep;
            const char* a2 = last ? nA : cA + (size_t)(t + 2) * kstep; const char* b2 = last ? nB : cB + (size_t)(t + 2) * kstep;
            const char* a3 = a2 + kstep; const char* b3 = b2 + kstep;
            if (last && has_next) S.a_ready(nxt);
            PG8_LDB(B0, 0, 0); PG8_SCHED; PG8_LDA(At, 0, 0); PG8_STAGE(PG8_SA(1, 1), a1 + hstep, voffA);
            PG8_WAIT_L(8); PG8_BAR; PG8_WAIT_L(0); PG8_MMA(0, 0, At, B0); PG8_BAR; PG8_SCHED;
            PG8_LDB(B1, 0, 1); PG8_STAGE(PG8_SB(0, 0), b2, voffB);
            PG8_BAR; PG8_WAIT_L(0); PG8_MMA(0, 1, At, B1); PG8_BAR;
            PG8_LDA(At, 0, 1); PG8_STAGE(PG8_SA(0, 0), a2, voffA);
            PG8_BAR; PG8_WAIT_L(0); PG8_MMA(1, 0, At, B0); PG8_BAR; PG8_SCHED;
            PG8_STAGE(PG8_SB(0, 1), b2 + hstep, voffB);
            PG8_WAIT_V(6); PG8_BAR; PG8_MMA(1, 1, At, B1); PG8_BAR;
            PG8_LDB(B0, 1, 0); PG8_SCHED; PG8_LDA(At, 1, 0); PG8_STAGE(PG8_SA(0, 1), a2 + hstep, voffA);
            PG8_WAIT_L(8); PG8_BAR; PG8_WAIT_L(0); PG8_MMA(0, 0, At, B0); PG8_BAR; PG8_SCHED;
            PG8_LDB(B1, 1, 1); PG8_STAGE(PG8_SB(1, 0), b3, voffB);
            PG8_BAR; PG8_WAIT_L(0); PG8_MMA(0, 1, At, B1); PG8_BAR;
            PG8_LDA(At, 1, 1); PG8_STAGE(PG8_SA(1, 0), a3, voffA);
            PG8_BAR; PG8_WAIT_L(0); PG8_MMA(1, 0, At, B0); PG8_BAR; PG8_SCHED;
            PG8_STAGE(PG8_SB(1, 1), b3 + hstep, voffB);
            PG8_WAIT_V(6); PG8_BAR; PG8_MMA(1, 1, At, B1); PG8_BAR;
        }
        E(acc, cur, wr, wc, fr, fq); S.done(cur);
        if (!has_next) break;
#pragma unroll
        for (int a = 0; a < 2; ++a)
#pragma unroll
            for (int b = 0; b < 2; ++b)
#pragma unroll
                for (int m = 0; m < 4; ++m)
#pragma unroll
                    for (int n = 0; n < 2; ++n) acc[a][b][m][n] = (f32x4){0.f, 0.f, 0.f, 0.f};
        cur = nxt; cA = nA; cB = nB; ++ui;
    }
    PG8_WAIT_V(0);
    if (wr == 0) PG8_BAR;
    PG8_BAR;
#undef PG8_SA
#undef PG8_SB
#undef PG8_STAGE
#undef PG8_LDA
#undef PG8_LDB
#undef PG8_MMA
#undef PG8_WAIT_V
#undef PG8_WAIT_L
#undef PG8_BAR
#undef PG8_SCHED
}
#else
template <class Epi, class Sched>
static inline void gemm_phase(unsigned char*, const Gemm g, const Sched& S, const Epi& E) {
    const int tid = threadIdx.x, wid = tid >> 6, lane = tid & 63, wr = wid >> 2, wc = wid & 3, fr = lane & 15, fq = lane >> 4;
    Unit u;
    for (int ui = 0; S.next(ui, u); ++ui) {
        f32x4 acc[2][2][4][2];
        for (int ai = 0; ai < 2; ++ai) for (int bj = 0; bj < 2; ++bj) for (int m = 0; m < 4; ++m) for (int n = 0; n < 2; ++n) for (int j = 0; j < 4; ++j) {
            const int r = 256 * u.pm + 128 * ai + 64 * wr + 16 * m + fr;
            const int c = Epi::PERM ? 256 * u.pn + 128 * bj + 32 * wc + 8 * fq + 4 * n + j : 256 * u.pn + 128 * bj + 32 * wc + 16 * n + 4 * fq + j;
            double s = 0; for (int k = u.pk * g.K; k < (u.pk + 1) * g.K; ++k) s += (double)bf2f(g.A[(size_t)r * g.ld + k]) * (double)bf2f(g.Bt[(size_t)c * g.ld + k]);
            acc[ai][bj][m][n][j] = (float)s; }
        E(acc, u, wr, wc, fr, fq);
    }
}
#endif
}

struct EpiStoreBf16 {
    static constexpr bool PERM = true;
    bf16_t* O; int ldc;
    DI void operator()(const f32x4 (&acc)[2][2][4][2], const pg8::Unit& u, int wr, int wc, int fr, int fq) const {
        const int row0 = u.pm * 256 + wr * 64 + fr, col0 = u.pn * 256 + wc * 32 + 8 * fq;
#pragma unroll
        for (int ai = 0; ai < 2; ++ai)
#pragma unroll
            for (int m = 0; m < 4; ++m) { bf16_t* rowp = O + (size_t)(row0 + ai * 128 + m * 16) * ldc + col0;
#pragma unroll
                for (int bj = 0; bj < 2; ++bj) { const f32x4 v0 = acc[ai][bj][m][0], v1 = acc[ai][bj][m][1];
                    u32x4 w; w.x = pack_bf2(v0[0], v0[1]); w.y = pack_bf2(v0[2], v0[3]); w.z = pack_bf2(v1[0], v1[1]); w.w = pack_bf2(v1[2], v1[3]);
                    *(u32x4*)(rowp + bj * 128) = w; } }
    }
};
template <bool IN_F32>
struct EpiResid {
    static constexpr bool PERM = true;
    const void* Xin; bf16_t* Xout; const float* gate;
    DI void operator()(const f32x4 (&acc)[2][2][4][2], const pg8::Unit& u, int wr, int wc, int fr, int fq) const {
        const int row0 = u.pm * 256 + wr * 64 + fr, col0 = u.pn * 256 + wc * 32 + 8 * fq;
        const float* gp = gate + (size_t)mod_index(u.pm * 256) * (NMOD * D) + col0;
        f32x4 gv[2][2];
#pragma unroll
        for (int bj = 0; bj < 2; ++bj)
#pragma unroll
            for (int n = 0; n < 2; ++n) gv[bj][n] = *(const f32x4*)(gp + bj * 128 + n * 4);
        if constexpr (IN_F32) {
            const float* Xf = (const float*)Xin;
#pragma unroll
            for (int am = 0; am < 4; ++am) { const int ai = am >> 1, mh = (am & 1) * 2; f32x4 xv[2][2][2];
#pragma unroll
                for (int m = 0; m < 2; ++m) { const size_t off = (size_t)(row0 + ai * 128 + (mh + m) * 16) * D + col0;
#pragma unroll
                    for (int bj = 0; bj < 2; ++bj)
#pragma unroll
                        for (int n = 0; n < 2; ++n) xv[m][bj][n] = *(const f32x4*)(Xf + off + bj * 128 + n * 4); }
                MEM_FENCE();
#pragma unroll
                for (int m = 0; m < 2; ++m) { const size_t off = (size_t)(row0 + ai * 128 + (mh + m) * 16) * D + col0;
#pragma unroll
                    for (int bj = 0; bj < 2; ++bj) { const f32x4 v0 = xv[m][bj][0] + gv[bj][0] * acc[ai][bj][mh + m][0], v1 = xv[m][bj][1] + gv[bj][1] * acc[ai][bj][mh + m][1];
                        u32x4 w; w.x = pack_bf2(v0[0], v0[1]); w.y = pack_bf2(v0[2], v0[3]); w.z = pack_bf2(v1[0], v1[1]); w.w = pack_bf2(v1[2], v1[3]);
                        *(u32x4*)(Xout + off + bj * 128) = w; } }
                MEM_FENCE(); }
        } else {
            const bf16_t* Xb = (const bf16_t*)Xin;
#pragma unroll
            for (int ai = 0; ai < 2; ++ai) { u32x4 xv[4][2];
#pragma unroll
                for (int m = 0; m < 4; ++m) { const size_t off = (size_t)(row0 + ai * 128 + m * 16) * D + col0;
#pragma unroll
                    for (int bj = 0; bj < 2; ++bj) xv[m][bj] = *(const u32x4*)(Xb + off + bj * 128); }
                MEM_FENCE();
#pragma unroll
                for (int m = 0; m < 4; ++m) { const size_t off = (size_t)(row0 + ai * 128 + m * 16) * D + col0;
#pragma unroll
                    for (int bj = 0; bj < 2; ++bj) { const u32x4 x = xv[m][bj];
                        const f32x4 x0 = {u_as_f(x.x << 16), u_as_f(x.x & 0xffff0000u), u_as_f(x.y << 16), u_as_f(x.y & 0xffff0000u)};
                        const f32x4 x1 = {u_as_f(x.z << 16), u_as_f(x.z & 0xffff0000u), u_as_f(x.w << 16), u_as_f(x.w & 0xffff0000u)};
                        const f32x4 v0 = x0 + gv[bj][0] * acc[ai][bj][m][0], v1 = x1 + gv[bj][1] * acc[ai][bj][m][1];
                        u32x4 w; w.x = pack_bf2(v0[0], v0[1]); w.y = pack_bf2(v0[2], v0[3]); w.z = pack_bf2(v1[0], v1[1]); w.w = pack_bf2(v1[2], v1[3]);
                        *(u32x4*)(Xout + off + bj * 128) = w; } }
                MEM_FENCE(); }
        }
    }
};
struct EpiPartial {
    static constexpr bool PERM = false;
    float* P;
    DI void operator()(const f32x4 (&acc)[2][2][4][2], const pg8::Unit& u, int wr, int wc, int fr, int fq) const {
        const int row0 = u.pm * 256 + wr * 64 + fr, col0 = u.pn * 256 + wc * 32 + 4 * fq;
        float* base = P + (size_t)u.pk * TC * D;
#pragma unroll
        for (int ai = 0; ai < 2; ++ai)
#pragma unroll
            for (int m = 0; m < 4; ++m) { float* xp = base + (size_t)(row0 + ai * 128 + m * 16) * D + col0;
#pragma unroll
                for (int bj = 0; bj < 2; ++bj)
#pragma unroll
                    for (int n = 0; n < 2; ++n) *(f32x4*)(xp + bj * 128 + n * 16) = acc[ai][bj][m][n]; }
    }
};
struct EpiSwiGLU {
    static constexpr bool PERM = true;
    bf16_t* O;
    DI void operator()(const f32x4 (&acc)[2][2][4][2], const pg8::Unit& u, int wr, int wc, int fr, int fq) const {
        const int row0 = u.pm * 256 + wr * 64 + fr, col0 = u.pn * 128 + wc * 32 + 8 * fq;
#pragma unroll
        for (int ai = 0; ai < 2; ++ai)
#pragma unroll
            for (int m = 0; m < 4; ++m) { bf16_t* rowp = O + (size_t)(row0 + ai * 128 + m * 16) * FF + col0;
                float r[8];
#pragma unroll
                for (int n = 0; n < 2; ++n)
#pragma unroll
                    for (int j = 0; j < 4; ++j) { const float gt = acc[ai][0][m][n][j], up = acc[ai][1][m][n][j]; r[n * 4 + j] = silu_fast(gt) * up; }
                u32x4 w; w.x = pack_bf2(r[0], r[1]); w.y = pack_bf2(r[2], r[3]); w.z = pack_bf2(r[4], r[5]); w.w = pack_bf2(r[6], r[7]);
                *(u32x4*)rowp = w; }
    }
};
struct EpiHgIn {
    static constexpr bool PERM = true;
    bf16_t* O; const float* lb;
    DI void operator()(const f32x4 (&acc)[2][2][4][2], const pg8::Unit& u, int wr, int wc, int fr, int fq) const {
        const int row0 = u.pm * 256 + wr * 64 + fr, col0 = u.pn * 256 + wc * 32 + 8 * fq;
        const int seg = (u.pn * 256) / D;
#pragma unroll
        for (int bj = 0; bj < 2; ++bj) {
            float lbv[8];
            if (seg >= 3) {
#pragma unroll
                for (int j = 0; j < 8; ++j) lbv[j] = lb[col0 + bj * 128 + j - 3 * D];
            }
#pragma unroll
            for (int ai = 0; ai < 2; ++ai)
#pragma unroll
                for (int m = 0; m < 4; ++m) { float r[8];
#pragma unroll
                    for (int n = 0; n < 2; ++n)
#pragma unroll
                        for (int j = 0; j < 4; ++j) { const float x = acc[ai][bj][m][n][j]; float y;
                            if (seg == 1) y = x;
                            else if (seg == 0 || seg == 2) y = silu_fast(x);
                            else { const float l = lbv[n * 4 + j], sg = fast_rcp(1.0f + fexp2(-1.4426950408889634f * x)); y = 0.6931471805599453f * flog2(l + (1.0f - l) * sg); }
                            r[n * 4 + j] = y; }
                    u32x4 w; w.x = pack_bf2(r[0], r[1]); w.y = pack_bf2(r[2], r[3]); w.z = pack_bf2(r[4], r[5]); w.w = pack_bf2(r[6], r[7]);
                    *(u32x4*)(O + (size_t)(row0 + ai * 128 + m * 16) * HG_N + col0 + bj * 128) = w; }
        }
    }
};
struct EpiGlaIn {
    static constexpr bool PERM = true;
    bf16_t* O; float* GA;
    DI void operator()(const f32x4 (&acc)[2][2][4][2], const pg8::Unit& u, int wr, int wc, int fr, int fq) const {
        const int row0 = u.pm * 256 + wr * 64 + fr, col0 = u.pn * 256 + wc * 32 + 8 * fq;
        if (u.pn == 24) {
            if (wc == 0) {
#pragma unroll
                for (int ai = 0; ai < 2; ++ai)
#pragma unroll
                    for (int m = 0; m < 4; ++m)
#pragma unroll
                        for (int n = 0; n < 2; ++n) *(f32x4*)(GA + (size_t)(row0 + ai * 128 + m * 16) * 32 + 8 * fq + 4 * n) = acc[ai][0][m][n];
            }
            return;
        }
        const int mode = u.pn < 4 ? 0 : (u.pn < 16 ? 1 : 2);
#pragma unroll
        for (int ai = 0; ai < 2; ++ai)
#pragma unroll
            for (int m = 0; m < 4; ++m)
#pragma unroll
                for (int bj = 0; bj < 2; ++bj) { float r[8];
#pragma unroll
                    for (int n = 0; n < 2; ++n)
#pragma unroll
                        for (int j = 0; j < 4; ++j) { const float x = acc[ai][bj][m][n][j]; r[n * 4 + j] = mode == 0 ? x * 0.0625f : (mode == 1 ? x : silu_fast(x)); }
                    u32x4 w; w.x = pack_bf2(r[0], r[1]); w.y = pack_bf2(r[2], r[3]); w.z = pack_bf2(r[4], r[5]); w.w = pack_bf2(r[6], r[7]);
                    *(u32x4*)(O + (size_t)(row0 + ai * 128 + m * 16) * GLA_NV + col0 + bj * 128) = w; }
    }
};

struct Ctx {
    const float* in[30]; float* out; unsigned char* ws;
    DI const float* x() const { return in[0]; }
    DI bf16_t* X() const { return (bf16_t*)(ws + WS_X); }
    DI bf16_t* HN() const { return (bf16_t*)(ws + WS_HN); }
    DI bf16_t* U() const { return (bf16_t*)(ws + WS_U); }
    DI float* O2() const { return (float*)(ws + WS_O2); }
    DI bf16_t* O4() const { return (bf16_t*)(ws + WS_O2); }
    DI bf16_t* Z2T() const { return (bf16_t*)(ws + WS_O2); }
    DI float* GA() const { return (float*)(ws + WS_GA); }
    DI float* MODV(int l) const { return (float*)(ws + WS_MODV) + (size_t)l * 5 * NMOD * D; }
    DI float* LB() const { return (float*)(ws + WS_LB); }
    DI float* HID2L(int j) const { return (float*)(ws + WS_HID2L) + (size_t)j * SEQ * 64; }
    DI float* HID2C(int j) const { return (float*)(ws + WS_HID2C) + (size_t)j * CL * 64; }
};

DI void transpose_weight(const float* src, bf16_t* dst, int K, int Nsrc, int Ndst, int mode, float* tile  , int t0, int t1, int wid, int nw) {
    const int tid = tidx(), nkt = K / 64, ntiles = t1;
    const int kk = tid >> 6, n4 = tid & 63;
    f32x4 r[2][8];
#define TW_LOAD(s_, tix_) do { if ((tix_) < ntiles) { const int kt_ = (tix_) % nkt, nt_ = (tix_) / nkt; int sc_ = nt_ * 256 + 4 * n4; \
        if (mode == 1) sc_ = (4 * n4 < 128) ? 128 * nt_ + 4 * n4 : FF + 128 * nt_ + (4 * n4 - 128); \
        _Pragma("unroll") for (int i = 0; i < 8; ++i) r[s_][i] = (sc_ < Nsrc) ? *(const f32x4*)(src + (size_t)(kt_ * 64 + kk + 8 * i) * Nsrc + sc_) : (f32x4){0.f, 0.f, 0.f, 0.f}; } } while (0)
#define TW_OUT(s_, tix_) do { if ((tix_) < ntiles) { const int k0 = ((tix_) % nkt) * 64, n0 = ((tix_) / nkt) * 256; const float* tl_ = tile + (s_) * (64 * 260); \
        const int nn = tid >> 1, kh = (tid & 1) * 32; bf16_t* dp = dst + (size_t)(n0 + nn) * K + k0 + kh; \
        _Pragma("unroll") for (int q = 0; q < 4; ++q) { float v[8]; \
            _Pragma("unroll") for (int i = 0; i < 8; ++i) v[i] = tl_[(kh + 8 * q + i) * 260 + nn]; \
            u32x4 w; w.x = pack_bf2(v[0], v[1]); w.y = pack_bf2(v[2], v[3]); w.z = pack_bf2(v[4], v[5]); w.w = pack_bf2(v[6], v[7]); \
            *(u32x4*)(dp + 8 * q) = w; } } } while (0)
    int tix = t0 + wid;
    TW_LOAD(0, tix); TW_LOAD(1, tix + nw);
    for (; tix < ntiles; tix += 2 * nw) {
        __syncthreads();
#pragma unroll
        for (int i = 0; i < 8; ++i) *(f32x4*)(tile + (kk + 8 * i) * 260 + 4 * n4) = r[0][i];
        if (tix + nw < ntiles) {
#pragma unroll
            for (int i = 0; i < 8; ++i) *(f32x4*)(tile + 64 * 260 + (kk + 8 * i) * 260 + 4 * n4) = r[1][i]; }
        __syncthreads();
        TW_LOAD(0, tix + 2 * nw); TW_LOAD(1, tix + 3 * nw);
        TW_OUT(0, tix); TW_OUT(1, tix + nw);
    }
#undef TW_LOAD
#undef TW_OUT
    __syncthreads();
}

constexpr int TPB = 14;
__host__ __device__ constexpr int inproj_n(int l) { return l % 3 == 0 ? HY_N : (l % 3 == 1 ? HG_N : GLA_NP); }
__host__ __device__ constexpr int idle_a(int l) { return l >= DEPTH - 1 ? 0 : (256 - ((TT / 256) * (inproj_n(l) / 256)) % 256) % 256; }
__host__ __device__ constexpr int idle_b(int l) { return l >= 2 ? 0 : (256 - ((TT / 256) * (2 * FF / 256)) % 256) % 256; }
__host__ __device__ constexpr int layer_tiles(int L) { return (D / 64) * (inproj_n(L) / 256) + (D / 64) * (D / 256) + (D / 64) * (2 * FF / 256) + (FF / 64) * (D / 256); }
__host__ __device__ constexpr int slot_a_end(int L) { return L == 0 ? 0 : (idle_a(L - 1) * (L == 1 ? 12 : TPB) < layer_tiles(L) ? idle_a(L - 1) * (L == 1 ? 12 : TPB) : layer_tiles(L)); }
__host__ __device__ constexpr int slot_b_end(int L) { return L == 0 ? 0 : (slot_a_end(L) + idle_b(L - 1) * TPB < layer_tiles(L) ? slot_a_end(L) + idle_b(L - 1) * TPB : layer_tiles(L)); }
constexpr int TPB_C = 11;
__host__ __device__ constexpr int slot_c_end(int L) { return (L == 0 || L > 2) ? slot_b_end(L) : (slot_b_end(L) + 128 * TPB_C < layer_tiles(L) ? slot_b_end(L) + 128 * TPB_C : layer_tiles(L)); }
__host__ __device__ constexpr int extra_c(int l) { return 128 * TPB_C - (slot_c_end(l + 1) - slot_b_end(l + 1)); }
__host__ __device__ constexpr int imin_c(int a, int b) { return a < b ? a : b; }
constexpr int L3_C0 = slot_a_end(3), L3_C1 = imin_c(L3_C0 + extra_c(0), layer_tiles(3)), L3_C2 = imin_c(L3_C1 + extra_c(1), layer_tiles(3));
static_assert(DEPTH == 4, "background slot arithmetic assumes four layers");
DI void convert_layer(const Ctx& c, int L, int t0, int t1, int wid, int nw, float* lf) {
    const int kind = L % 3, j = L / 3;
    int base = 0;
#pragma unroll 1
    for (int m = 0; m < 4; ++m) {
        const float* src; bf16_t* dst; int K = D, nsrc = D, ndst = D, mode = 0;
        if (m == 0) {
            if (kind == 0) { src = c.in[11] + (size_t)j * D * HY_N; dst = (bf16_t*)(c.ws + WS_WHYIN) + (size_t)j * HY_N * D; nsrc = HY_N; ndst = HY_N; }
            else if (kind == 1) { src = c.in[21]; dst = (bf16_t*)(c.ws + WS_WHGIN); nsrc = HG_N; ndst = HG_N; }
            else { src = c.in[25]; dst = (bf16_t*)(c.ws + WS_WGLIN); nsrc = GLA_N; ndst = GLA_NP; }
        } else if (m == 1) {
            if (kind == 0) { src = c.in[20] + (size_t)j * D * D; dst = (bf16_t*)(c.ws + WS_WHYOUT) + (size_t)j * D * D; }
            else if (kind == 1) { src = c.in[24]; dst = (bf16_t*)(c.ws + WS_WHGOUT); }
            else { src = c.in[29]; dst = (bf16_t*)(c.ws + WS_WGLOUT); }
        } else if (m == 2) { src = c.in[8] + (size_t)L * D * 2 * FF; dst = (bf16_t*)(c.ws + WS_WFIN) + (size_t)L * 2 * FF * D; nsrc = 2 * FF; ndst = 2 * FF; mode = 1; }
        else { src = c.in[9] + (size_t)L * FF * D; dst = (bf16_t*)(c.ws + WS_WFOUT) + (size_t)L * D * FF; K = FF; }
        const int nt = (K / 64) * (ndst / 256);
        const int lo = t0 - base > 0 ? t0 - base : 0, hi = t1 - base < nt ? t1 - base : nt;
        if (lo < hi) transpose_weight(src, dst, K, nsrc, ndst, mode, lf, lo, hi, wid, nw);
        base += nt;
    }
}

DI void modv_items(const Ctx& c, float* lds_f) {
    float* sc = lds_f;
    float* part = lds_f + 5 * D;
    const int tid = tidx(), lane = tid & 63, kq = tid >> 6;
    constexpr int CW = 192, CPL = NMOD * D / CW;
    const int nitems = DEPTH * CPL;
    bool have_sc = false;
    for (int it = (int)gridDim.x - 1 - (int)blockIdx.x; it < nitems; it += gridDim.x) {
        if (!have_sc) { for (int i = tid; i < 5 * D; i += NTHREADS) { const int r = i / D, k = i % D; const float v = r < 4 ? c.in[1][r * D + k] : c.in[3][k]; sc[i] = silu_f(v); } have_sc = true; }
        __syncthreads();
        const int l = it / CPL, cb = it % CPL;
        const float* wp = c.in[4] + (size_t)l * D * (NMOD * D) + cb * CW + 4 * lane;
        float a[5][4];
#pragma unroll
        for (int r = 0; r < 5; ++r)
#pragma unroll
            for (int j = 0; j < 4; ++j) a[r][j] = 0.f;
        if (lane < CW / 4) {
#pragma unroll 8
            for (int k = kq; k < D; k += 8) { const float4 w = *(const float4*)(wp + (size_t)k * (NMOD * D));
#pragma unroll
                for (int r = 0; r < 5; ++r) { const float s = sc[r * D + k]; a[r][0] += s * w.x; a[r][1] += s * w.y; a[r][2] += s * w.z; a[r][3] += s * w.w; } } }
#pragma unroll
        for (int r = 0; r < 5; ++r)
#pragma unroll
            for (int j = 0; j < 4; ++j) part[(kq * 5 + r) * 256 + 4 * lane + j] = a[r][j];
        __syncthreads();
        for (int o = tid; o < 5 * 256; o += NTHREADS) { const int r = o / 256, n = o % 256;
            if (n < CW) { float s = c.in[5][(size_t)l * NMOD * D + cb * CW + n];
#pragma unroll
                for (int q = 0; q < 8; ++q) s += part[(q * 5 + r) * 256 + n];
                c.MODV(l)[(size_t)r * NMOD * D + cb * CW + n] = s; } }
        __syncthreads();
    }
}

DI void hid2_items(const Ctx& c, float* lds_f) {
    float* zb = lds_f;
    float* h1 = lds_f + 8 * 36;
    const int tid = tidx(), p = tid >> 6, j = tid & 63;
    const int per_layer = (SEQ + CL) / 8, nitems = 2 * per_layer;
    for (int it = blockIdx.x; it < nitems; it += gridDim.x) {
        const int jl = it / per_layer, r = it % per_layer;
        const bool isl = r < SEQ / 8; const int L = isl ? SEQ : CL; const int pos = (isl ? r : r - SEQ / 8) * 8 + p;
        if (j < 33) { float z;
            if (j == 0) z = (float)pos / (float)(L - 1);
            else { const int band = (j <= 16) ? j : j - 16; const int ph = (pos * band) & (L - 1); const float rev = (float)ph / (float)L;
                   z = (j <= 16) ? cosf(6.283185307179586f * rev) : -sinf(6.283185307179586f * rev); }
            zb[p * 36 + j] = z; }
        __syncthreads();
        {   const float* fw1 = c.in[13] + (size_t)jl * 33 * 64; float s = c.in[14][jl * 64 + j];
            for (int i = 0; i < 33; ++i) s += zb[p * 36 + i] * fw1[i * 64 + j];
            h1[p * 64 + j] = sinf(c.in[15][(jl * 2 + 0) * 64 + j] * s); }
        __syncthreads();
        {   const float* fw2 = c.in[16] + (size_t)jl * 64 * 64; float s = c.in[17][jl * 64 + j];
            for (int i = 0; i < 64; ++i) s += h1[p * 64 + i] * fw2[i * 64 + j];
            const float o = sinf(c.in[15][(jl * 2 + 1) * 64 + j] * s);
            (isl ? c.HID2L(jl) : c.HID2C(jl))[(size_t)pos * 64 + j] = o; }
        __syncthreads();
    }
}

DI void prologue_phase(const Ctx& c, unsigned char* lds) {
    float* lf = (float*)lds;
    {   const bool bg = gridDim.x == 256;
#pragma unroll 1
        for (int L = 0; L < DEPTH; ++L) convert_layer(c, L, bg ? (L == 3 ? L3_C2 : slot_c_end(L)) : 0, layer_tiles(L), blockIdx.x, gridDim.x, lf); }
    modv_items(c, lf);
    __syncthreads();
    hid2_items(c, lf);
    for (int i = blockIdx.x * NTHREADS + tidx(); i < 2 * D; i += gridDim.x * NTHREADS) {
        const int dir = i / D, d = i % D; const float* lg = c.in[22] + (size_t)dir * DEPTH * D + d;
        const float l0 = lg[0], l1 = lg[D], l2 = lg[2 * D], l3 = lg[3 * D]; const float mx = fmaxf(fmaxf(l0, l1), fmaxf(l2, l3));
        const float e0 = expf(l0 - mx), e1 = expf(l1 - mx), e2 = expf(l2 - mx), e3 = expf(l3 - mx);
        c.LB()[i] = e1 / (e0 + e1 + e2 + e3);
    }
}

template <bool F32> struct XRawT { typedef float4 type; };
template <> struct XRawT<false> { typedef u32x2 type; };
DI float4 cvt4(const float4& r) { return r; }
DI float4 cvt4(const u32x2& r) { return make_float4(u_as_f(r.x << 16), u_as_f(r.x & 0xffff0000u), u_as_f(r.y << 16), u_as_f(r.y & 0xffff0000u)); }
template <bool F32> DI typename XRawT<F32>::type ldx(const void* p, size_t e) {
    if constexpr (F32) return *(const float4*)((const float*)p + e); else return *(const u32x2*)((const bf16_t*)p + e); }
template <int NP> DI void fold_parts(float4 (&v)[8], const float4 (&gt)[8], const float* Pr) {
    constexpr int NI = 16 / NP;
#pragma unroll
    for (int ib = 0; ib < 8; ib += NI) { float4 p[NI][NP];
#pragma unroll
        for (int q = 0; q < NI; ++q)
#pragma unroll
            for (int k = 0; k < NP; ++k) p[q][k] = *(const float4*)(Pr + (size_t)k * TC * D + (ib + q) * 256);
        MEM_FENCE();
#pragma unroll
        for (int q = 0; q < NI; ++q) { float4 s = make_float4(0.f, 0.f, 0.f, 0.f);
#pragma unroll
            for (int k = 0; k < NP; ++k) { s.x += p[q][k].x; s.y += p[q][k].y; s.z += p[q][k].z; s.w += p[q][k].w; }
            const int i = ib + q; v[i].x += gt[i].x * s.x; v[i].y += gt[i].y * s.y; v[i].z += gt[i].z * s.z; v[i].w += gt[i].w * s.w; } }
}
template <bool LF32, bool CF32>
DI void norm_mod_phase(const void* Xl, const void* Xc, bf16_t* Xcw, const float* g, const float* modv_l, int shift_i, int scale_i, bf16_t* HNp, int nrows, const float* P, int nparts, const float* pgate) {
    typedef typename XRawT<LF32>::type raw_t;
    const int tid_ = tidx(); const int lane = tid_ & 63, wv = tid_ >> 6;
    const int gw = blockIdx.x * 8 + wv, nw = gridDim.x * 8;
    const int nlat = nrows < T ? nrows : T;
    if constexpr (!LF32) {
    const bf16_t* Xb = (const bf16_t*)Xl;
    for (int base = gw * 8; base < nlat; base += nw * 8) {
        const float* mv = modv_l + (size_t)(base / SEQ) * NMOD * D;
        u32x4 nx[4], ny[4], nz[4], nw4[4];
#pragma unroll
        for (int i = 0; i < 4; ++i) { nx[i] = *(const u32x4*)(Xb + (size_t)base * D + i * 512 + lane * 8); ny[i] = *(const u32x4*)(Xb + (size_t)(base + 1) * D + i * 512 + lane * 8);
            nz[i] = *(const u32x4*)(Xb + (size_t)(base + 2) * D + i * 512 + lane * 8); nw4[i] = *(const u32x4*)(Xb + (size_t)(base + 3) * D + i * 512 + lane * 8); }
        float4 ca[8], cb[8];
        {   f32x4 ra[12], rb[12];
#pragma unroll
            for (int i = 0; i < 8; ++i) { const int e = (i >> 1) * 512 + lane * 8 + (i & 1) * 4; const f32x4 gq = *(const f32x4*)(g + e), sq = *(const f32x4*)(mv + scale_i * D + e), hq = *(const f32x4*)(mv + shift_i * D + e);
                ra[i] = gq; if (i < 4) ra[8 + i] = sq; else rb[i - 4] = sq; rb[4 + i] = hq; }
            PIN12(ra); PIN12(rb);
#pragma unroll
            for (int i = 0; i < 8; ++i) { const f32x4 gq = ra[i], sq = i < 4 ? ra[8 + i] : rb[i - 4], hq = rb[4 + i];
                ca[i] = make_float4(gq[0] * (1.0f + sq[0]), gq[1] * (1.0f + sq[1]), gq[2] * (1.0f + sq[2]), gq[3] * (1.0f + sq[3])); cb[i] = make_float4(hq[0], hq[1], hq[2], hq[3]); } }
#pragma unroll 2
        for (int r = 0; r < 8; ++r) { const int row = base + r; float4 v[8]; float ss = 0.f;
#pragma unroll
            for (int i = 0; i < 4; ++i) { const u32x4 x = nx[i]; nx[i] = ny[i]; ny[i] = nz[i]; nz[i] = nw4[i];
                v[2 * i] = make_float4(u_as_f(x.x << 16), u_as_f(x.x & 0xffff0000u), u_as_f(x.y << 16), u_as_f(x.y & 0xffff0000u));
                v[2 * i + 1] = make_float4(u_as_f(x.z << 16), u_as_f(x.z & 0xffff0000u), u_as_f(x.w << 16), u_as_f(x.w & 0xffff0000u)); }
            if (r < 4) {
#pragma unroll
                for (int i = 0; i < 4; ++i) nw4[i] = *(const u32x4*)(Xb + (size_t)(row + 4) * D + i * 512 + lane * 8); }
#pragma unroll
            for (int i = 0; i < 8; ++i) ss += v[i].x * v[i].x + v[i].y * v[i].y + v[i].z * v[i].z + v[i].w * v[i].w;
            ss = wave_sum(ss);
            const float rstd = rsqrtf(ss * (1.0f / D) + RMS_EPS);
#pragma unroll
            for (int i = 0; i < 4; ++i) { const int a = 2 * i, b = 2 * i + 1; u32x4 w;
                w.x = pack_bf2(v[a].x * rstd * ca[a].x + cb[a].x, v[a].y * rstd * ca[a].y + cb[a].y); w.y = pack_bf2(v[a].z * rstd * ca[a].z + cb[a].z, v[a].w * rstd * ca[a].w + cb[a].w);
                w.z = pack_bf2(v[b].x * rstd * ca[b].x + cb[b].x, v[b].y * rstd * ca[b].y + cb[b].y); w.w = pack_bf2(v[b].z * rstd * ca[b].z + cb[b].z, v[b].w * rstd * ca[b].w + cb[b].w);
                *(u32x4*)(HNp + (size_t)row * D + i * 512 + lane * 8) = w; } }
    }
    } else {
    for (int base = gw * 8; base < nlat; base += nw * 8) {
        const float* mv = modv_l + (size_t)(base / SEQ) * NMOD * D;
        float4 ca[8], cb[8];
#pragma unroll
        for (int i = 0; i < 8; ++i) { const int e = i * 256 + lane * 4; const float4 gg = *(const float4*)(g + e), sc = *(const float4*)(mv + scale_i * D + e); cb[i] = *(const float4*)(mv + shift_i * D + e);
            ca[i] = make_float4(gg.x * (1.0f + sc.x), gg.y * (1.0f + sc.y), gg.z * (1.0f + sc.z), gg.w * (1.0f + sc.w)); }
        raw_t nx[8], ny[8];
#pragma unroll
        for (int i = 0; i < 8; ++i) { nx[i] = ldx<LF32>(Xl, (size_t)base * D + i * 256 + lane * 4); ny[i] = ldx<LF32>(Xl, (size_t)(base + 1) * D + i * 256 + lane * 4); }
#pragma unroll 2
        for (int r = 0; r < 8; ++r) { const int row = base + r; float4 v[8]; float ss = 0.f;
#pragma unroll
            for (int i = 0; i < 8; ++i) { v[i] = cvt4(nx[i]); nx[i] = ny[i]; }
            if (r < 6) {
#pragma unroll
                for (int i = 0; i < 8; ++i) ny[i] = ldx<LF32>(Xl, (size_t)(row + 2) * D + i * 256 + lane * 4); }
#pragma unroll
            for (int i = 0; i < 8; ++i) ss += v[i].x * v[i].x + v[i].y * v[i].y + v[i].z * v[i].z + v[i].w * v[i].w;
            ss = wave_sum(ss);
            const float rstd = rsqrtf(ss * (1.0f / D) + RMS_EPS);
#pragma unroll
            for (int i = 0; i < 8; ++i) { const int e = i * 256 + lane * 4;
                u32x2 w; w.x = pack_bf2(v[i].x * rstd * ca[i].x + cb[i].x, v[i].y * rstd * ca[i].y + cb[i].y); w.y = pack_bf2(v[i].z * rstd * ca[i].z + cb[i].z, v[i].w * rstd * ca[i].w + cb[i].w);
                *(u32x2*)(HNp + (size_t)row * D + e) = w; } }
    }
    }
    for (int row = T + gw; row < nrows; row += nw) {
        float4 v[8]; float ss = 0.f;
#pragma unroll
        for (int i = 0; i < 8; ++i) v[i] = cvt4(ldx<CF32>(Xc, (size_t)(row - T) * D + i * 256 + lane * 4));
        if (nparts > 0) {
            float4 gt[8];
#pragma unroll
            for (int i = 0; i < 8; ++i) gt[i] = *(const float4*)(pgate + i * 256 + lane * 4);
            const float* Pr = P + (size_t)(row - T) * D + lane * 4;
            if (nparts == 8) fold_parts<8>(v, gt, Pr); else fold_parts<4>(v, gt, Pr);
#pragma unroll
            for (int i = 0; i < 8; ++i) { u32x2 w; w.x = pack_bf2(v[i].x, v[i].y); w.y = pack_bf2(v[i].z, v[i].w);
                *(u32x2*)(Xcw + (size_t)(row - T) * D + i * 256 + lane * 4) = w; } }
        const float* mv = modv_l + (size_t)NBATCH * NMOD * D;
        f32x4 ra[12], rb[12];
#pragma unroll
        for (int i = 0; i < 8; ++i) { const int e = i * 256 + lane * 4; const f32x4 gq = *(const f32x4*)(g + e), sq = *(const f32x4*)(mv + scale_i * D + e), hq = *(const f32x4*)(mv + shift_i * D + e);
            ra[i] = gq; if (i < 4) ra[8 + i] = sq; else rb[i - 4] = sq; rb[4 + i] = hq; }
#pragma unroll
        for (int i = 0; i < 8; ++i) ss += v[i].x * v[i].x + v[i].y * v[i].y + v[i].z * v[i].z + v[i].w * v[i].w;
        ss = wave_sum(ss);
        const float rstd = rsqrtf(ss * (1.0f / D) + RMS_EPS);
        PIN12(ra); PIN12(rb);
#pragma unroll
        for (int i = 0; i < 8; ++i) { const f32x4 gq = ra[i], sq = i < 4 ? ra[8 + i] : rb[i - 4], hq = rb[4 + i]; const int e = i * 256 + lane * 4;
            u32x2 w; w.x = pack_bf2(v[i].x * rstd * gq[0] * (1.0f + sq[0]) + hq[0], v[i].y * rstd * gq[1] * (1.0f + sq[1]) + hq[1]);
            w.y = pack_bf2(v[i].z * rstd * gq[2] * (1.0f + sq[2]) + hq[2], v[i].w * rstd * gq[3] * (1.0f + sq[3]) + hq[3]);
            *(u32x2*)(HNp + (size_t)row * D + e) = w; }
    }
}
DI void final_norm_phase(const bf16_t* X, const float* g, float* out, int nrows) {
    const int tid_ = tidx(); const int lane = tid_ & 63, wv = tid_ >> 6;
    const int gw = blockIdx.x * 8 + wv, nw = gridDim.x * 8;
    float4 gg[8];
#pragma unroll
    for (int i = 0; i < 8; ++i) gg[i] = *(const float4*)(g + i * 256 + lane * 4);
    for (int base = gw * 8; base < nrows; base += nw * 8) {
        u32x2 nx[8], ny[8];
#pragma unroll
        for (int i = 0; i < 8; ++i) { nx[i] = *(const u32x2*)(X + (size_t)base * D + i * 256 + lane * 4); ny[i] = *(const u32x2*)(X + (size_t)(base + 1) * D + i * 256 + lane * 4); }
#pragma unroll 2
        for (int r = 0; r < 8; ++r) { const int row = base + r; float4 v[8]; float ss = 0.f;
#pragma unroll
            for (int i = 0; i < 8; ++i) { v[i] = cvt4(nx[i]); nx[i] = ny[i]; }
            if (r < 6) {
#pragma unroll
                for (int i = 0; i < 8; ++i) ny[i] = *(const u32x2*)(X + (size_t)(row + 2) * D + i * 256 + lane * 4); }
#pragma unroll
            for (int i = 0; i < 8; ++i) ss += v[i].x * v[i].x + v[i].y * v[i].y + v[i].z * v[i].z + v[i].w * v[i].w;
            ss = wave_sum(ss);
            const float rstd = rsqrtf(ss * (1.0f / D) + RMS_EPS);
#pragma unroll
            for (int i = 0; i < 8; ++i) *(float4*)(out + (size_t)row * D + i * 256 + lane * 4) = make_float4(v[i].x * rstd * gg[i].x, v[i].y * rstd * gg[i].y, v[i].z * rstd * gg[i].z, v[i].w * rstd * gg[i].w); }
    }
}
template <int HS>
DI void headnorm_phase(const bf16_t* O4p, const float* g, const bf16_t* Up, int ldu, int goff, bf16_t* Z, int nrows) {
    const int tid_ = tidx(); const int lane = tid_ & 63, wv = tid_ >> 6;
    for (int row = blockIdx.x * 8 + wv; row < nrows; row += gridDim.x * 8) {
        const bf16_t* o0 = O4p + (size_t)row * D;
        float4 v[8]; float ss[8];
#pragma unroll
        for (int i = 0; i < 8; ++i) { const int e = i * 256 + lane * 4;
            const u16x4 a = *(const u16x4*)(o0 + e), b = *(const u16x4*)(o0 + (size_t)TT * D + e), cc = *(const u16x4*)(o0 + (size_t)2 * TT * D + e), dd = *(const u16x4*)(o0 + (size_t)3 * TT * D + e);
            v[i] = make_float4((bf2f(a[0]) + bf2f(b[0])) + (bf2f(cc[0]) + bf2f(dd[0])), (bf2f(a[1]) + bf2f(b[1])) + (bf2f(cc[1]) + bf2f(dd[1])),
                               (bf2f(a[2]) + bf2f(b[2])) + (bf2f(cc[2]) + bf2f(dd[2])), (bf2f(a[3]) + bf2f(b[3])) + (bf2f(cc[3]) + bf2f(dd[3])));
            ss[i] = v[i].x * v[i].x + v[i].y * v[i].y + v[i].z * v[i].z + v[i].w * v[i].w; }
        float rs[8];
        if (HS == 128) {
#pragma unroll
            for (int i = 0; i < 8; ++i) { float s = ss[i]; s += shfl_xor_f(s, 16); s += shfl_xor_f(s, 8); s += shfl_xor_f(s, 4); s += shfl_xor_f(s, 2); s += shfl_xor_f(s, 1); rs[i] = rsqrtf(s * (1.0f / 128.0f) + RMS_EPS); }
        } else {
#pragma unroll
            for (int i = 0; i < 8; i += 2) { const float s = wave_sum(ss[i] + ss[i + 1]); rs[i] = rs[i + 1] = rsqrtf(s * (1.0f / 512.0f) + RMS_EPS); }
        }
#pragma unroll
        for (int i = 0; i < 8; ++i) { const int e = i * 256 + lane * 4; const float4 gg = *(const float4*)(g + e);
            const u16x4 sg = *(const u16x4*)(Up + (size_t)row * ldu + goff + e);
            u32x2 w; w.x = pack_bf2(v[i].x * rs[i] * gg.x * bf2f(sg[0]), v[i].y * rs[i] * gg.y * bf2f(sg[1]));
            w.y = pack_bf2(v[i].z * rs[i] * gg.z * bf2f(sg[2]), v[i].w * rs[i] * gg.w * bf2f(sg[3]));
            *(u32x2*)(Z + (size_t)row * D + e) = w; }
    }
}
DI void transpose_z_phase(const bf16_t* Z2Tp, bf16_t* Z, int ntok, unsigned char* lds) {
    bf16_t* tile = (bf16_t*)lds;
    const int tid = tidx(), ntt = ntok / 256, ntiles = ntt * (D / 64);
    const int ch = tid >> 3, t8 = tid & 7;
    int tix = blockIdx.x; u32x4 nx[4];
#define TZ_LOAD(t_) do { const bf16_t* p_ = Z2Tp + (size_t)(((t_) / ntt) * 64 + ch) * TT + ((t_) % ntt) * 256 + 8 * t8; \
        _Pragma("unroll") for (int i = 0; i < 4; ++i) nx[i] = *(const u32x4*)(p_ + 64 * i); } while (0)
    if (tix < ntiles) TZ_LOAD(tix);
    for (; tix < ntiles; tix += gridDim.x) {
        const int c0 = (tix / ntt) * 64, t0 = (tix % ntt) * 256;
        __syncthreads();
#pragma unroll
        for (int i = 0; i < 4; ++i) *(u32x4*)(tile + ch * 264 + 64 * i + 8 * t8) = nx[i];
        if (tix + (int)gridDim.x < ntiles) TZ_LOAD(tix + (int)gridDim.x);
        __syncthreads();
        {   const int tok = tid >> 1, hb = (tid & 1) * 32;
#pragma unroll
            for (int q = 0; q < 4; ++q) { unsigned short r[8];
#pragma unroll
                for (int i = 0; i < 8; ++i) r[i] = tile[(hb + 8 * q + i) * 264 + tok];
                u32x4 w; w.x = r[0] | ((unsigned)r[1] << 16); w.y = r[2] | ((unsigned)r[3] << 16); w.z = r[4] | ((unsigned)r[5] << 16); w.w = r[6] | ((unsigned)r[7] << 16);
                *(u32x4*)(Z + (size_t)(t0 + tok) * D + c0 + hb + 8 * q) = w; } }
    }
#undef TZ_LOAD
    __syncthreads();
}

constexpr float LOG2E = 1.4426950408889634f;
template <int DK, int DV, int NH, bool IS_GLA>
DI void scan_prep_phase(const Ctx& c, unsigned char* lds) {
    constexpr int QS = DK + 8, TS = 72, NSEG = NTHREADS / DK, SEGLEN = 64 / NSEG, NCH = DK / 64, NVS = NTHREADS / DV, VLEN = 64 / NVS;
    constexpr int LDU = IS_GLA ? GLA_NV : HG_N, NBHC = 4 * NH * 68;
    bf16_t* qt = (bf16_t*)lds;
    bf16_t* kt = qt + 64 * QS;
    bf16_t* vT = kt + 64 * QS;
    bf16_t* att = vT + DV * TS;
    float* segsum = (float*)(att + 64 * TS);
    float* abuf = segsum + NSEG * DK;
    const int tid = tidx(), lane = tid & 63, w = tid >> 6, fr = lane & 15, fq = lane >> 4;
    const bf16_t* Up = c.U();
    bf16_t* QTg = (bf16_t*)(c.ws + WS_PQT); bf16_t* KTg = (bf16_t*)(c.ws + WS_PKT); bf16_t* VTg = (bf16_t*)(c.ws + WS_PVT); float* EMg = (float*)(c.ws + WS_PEM);
    const int d = tid % DK, seg = tid / DK;
    u32x4 rq[NCH], rk[NCH]; f32x4 ra = (f32x4){0.f, 0.f, 0.f, 0.f};
#define PREP_DECODE(u_, chunk_, dir_, h_, b_, r0_) const int chunk_ = (u_) % 68, dir_ = ((u_) / 68) & 1, h_ = ((u_) / 136) % NH, b_ = (u_) / (136 * NH); \
        const int r0_ = chunk_ < 4 ? T + b_ * CL + 64 * chunk_ : b_ * SEQ + 64 * (chunk_ - 4)
#define PREP_LOAD(u_) do { PREP_DECODE(u_, ch_, di_, hh_, bb_, rr_); \
        const int q0_ = IS_GLA ? hh_ * 256 : hh_ * 128, k0_ = IS_GLA ? 1024 + hh_ * 256 : 6144 + di_ * D + hh_ * 128; \
        _Pragma("unroll") for (int i = 0; i < NCH; ++i) { const int ci = tid + NTHREADS * i, t = ci / (DK / 8), c8 = ci % (DK / 8); \
            rq[i] = *(const u32x4*)(Up + (size_t)(rr_ + t) * LDU + q0_ + 8 * c8); if (!IS_GLA) rk[i] = *(const u32x4*)(Up + (size_t)(rr_ + t) * LDU + k0_ + 8 * c8); } \
        if (IS_GLA && tid < 256) ra = *(const f32x4*)(c.GA() + (size_t)(rr_ + (tid >> 2)) * 32 + di_ * 16 + 4 * (tid & 3)); } while (0)
    if ((int)blockIdx.x < 2 * NBHC) PREP_LOAD((int)blockIdx.x);
    for (int u = blockIdx.x; u < 2 * NBHC; u += gridDim.x) {
        PREP_DECODE(u, chunk, dir, h, b, r0);
        const int bhc = (b * NH + h) * 68 + chunk;
        const int ucv = IS_GLA ? 2048 + h * 512 : 2048 + h * 128;
        float wup[16], bup = 0.f;
        if (IS_GLA) {
#pragma unroll
            for (int r = 0; r < 16; ++r) wup[r] = c.in[26][((size_t)dir * 16 + r) * 1024 + h * 256 + d];
            bup = c.in[27][(size_t)dir * 1024 + h * 256 + d]; }
        u32x4 kk[NCH];
        if (IS_GLA) {
#pragma unroll
            for (int i = 0; i < NCH; ++i) { const int ci = tid + NTHREADS * i, t = ci / (DK / 8), c8 = ci % (DK / 8); kk[i] = *(const u32x4*)(Up + (size_t)(r0 + t) * LDU + 1024 + h * 256 + 8 * c8); } }
        lds_barrier();
#pragma unroll
        for (int i = 0; i < NCH; ++i) { const int ci = tid + NTHREADS * i, t = ci / (DK / 8), c8 = ci % (DK / 8);
            *(u32x4*)(qt + t * QS + 8 * c8) = rq[i];
            *(u32x4*)(kt + t * QS + 8 * c8) = IS_GLA ? kk[i] : rk[i]; }
        if (IS_GLA && tid < 256) *(f32x4*)(abuf + (tid >> 2) * 16 + 4 * (tid & 3)) = ra;
        unsigned short ev[VLEN];
        {   const int vv = tid % DV, vs = tid / DV; const bf16_t* vp = Up + (size_t)(r0 + vs * VLEN) * LDU + ucv + vv;
#pragma unroll
            for (int i = 0; i < VLEN; ++i) ev[i] = vp[(size_t)i * LDU]; }
        if (u + (int)gridDim.x < 2 * NBHC) PREP_LOAD(u + (int)gridDim.x);
        lds_barrier();
        float cs[SEGLEN];
        {   float run = 0.f;
#pragma unroll
            for (int ii = 0; ii < SEGLEN; ++ii) { const int i = dir ? SEGLEN - 1 - ii : ii; const int t = seg * SEGLEN + i; float g2;
                if (IS_GLA) { float xx = bup;
#pragma unroll
                    for (int r4 = 0; r4 < 4; ++r4) { const f32x4 av = *(const f32x4*)(abuf + t * 16 + 4 * r4);
                        xx += av[0] * wup[4 * r4] + av[1] * wup[4 * r4 + 1] + av[2] * wup[4 * r4 + 2] + av[3] * wup[4 * r4 + 3]; }
                    g2 = (fminf(xx, 0.f) * LOG2E - flog2(1.0f + fexp2(-fabsf(xx) * LOG2E))) * 0.0625f; }
                else g2 = bf2f(kt[t * QS + d]) * LOG2E;
                run += g2; cs[i] = run; }
            segsum[seg * DK + d] = run; }
        lds_barrier();
        {   float prefix = 0.f, bmid = 0.f, btot = 0.f;
#pragma unroll
            for (int s = 0; s < NSEG; ++s) { const float v = segsum[s * DK + d]; const bool before = dir ? (s > seg) : (s < seg), first_half = dir ? (s >= NSEG / 2) : (s < NSEG / 2);
                if (before) prefix += v; if (first_half) bmid += v; btot += v; }
            unsigned kpk[SEGLEN / 2];
#pragma unroll
            for (int i = 0; i < SEGLEN; ++i) { const int t = seg * SEGLEN + i; const float bc = prefix + cs[i];
                const float kraw = bf2f(kt[t * QS + d]); const float kv = IS_GLA ? kraw : 1.0f - fexp2(kraw * LOG2E);
                const float qv = bf2f(qt[t * QS + d]);
                const bf16_t qb = f2bf(qv * fexp2(fminf(bc - bmid, 115.f))), kb = f2bf(kv * fexp2(fminf(bmid - bc, 115.f)));
                qt[t * QS + d] = qb; kt[t * QS + d] = kb;
                if (i & 1) kpk[i / 2] |= (unsigned)kb << 16; else kpk[i / 2] = kb; }
            bf16_t* kg = KTg + ((size_t)dir * NBHC + bhc) * (DK * 64) + (size_t)d * 64 + seg * SEGLEN;
#pragma unroll
            for (int i8 = 0; i8 < SEGLEN / 8; ++i8) { u32x4 pk; pk.x = kpk[4 * i8]; pk.y = kpk[4 * i8 + 1]; pk.z = kpk[4 * i8 + 2]; pk.w = kpk[4 * i8 + 3]; *(u32x4*)(kg + 8 * i8) = pk; }
            if (seg == 0) { float* em = EMg + ((size_t)dir * NBHC + bhc) * (2 * DK); em[d] = fexp2(bmid); em[DK + d] = fexp2(btot - bmid); } }
        lds_barrier();
        {   const int tt = w & 3, st0 = 2 * (w >> 2);
            f32x4 a0 = (f32x4){0.f, 0.f, 0.f, 0.f}, a1 = a0;
#pragma unroll
            for (int k0 = 0; k0 < DK; k0 += 32) { const bf16x8 y = *(const bf16x8*)(qt + (16 * tt + fr) * QS + k0 + 8 * fq);
                const bf16x8 x0 = *(const bf16x8*)(kt + (16 * st0 + fr) * QS + k0 + 8 * fq), x1 = *(const bf16x8*)(kt + (16 * (st0 + 1) + fr) * QS + k0 + 8 * fq);
                a0 = mma16(x0, y, a0); a1 = mma16(x1, y, a1); }
            const int t = 16 * tt + fr;
#pragma unroll
            for (int q = 0; q < 2; ++q) { const f32x4 a = q ? a1 : a0; const int s0 = 16 * (st0 + q) + 4 * fq; float m[4];
#pragma unroll
                for (int jj = 0; jj < 4; ++jj) m[jj] = (dir ? (s0 + jj >= t) : (s0 + jj <= t)) ? a[jj] : 0.f;
                u32x2 ww; ww.x = pack_bf2(m[0], m[1]); ww.y = pack_bf2(m[2], m[3]); *(u32x2*)(att + t * TS + s0) = ww; } }
#pragma unroll
        for (int i = 0; i < NCH; ++i) { const int ci = tid + NTHREADS * i, t = ci / (DK / 8), c8 = ci % (DK / 8);
            *(u32x4*)(QTg + ((size_t)dir * TT + r0 + t) * (NH * DK) + h * DK + 8 * c8) = *(const u32x4*)(qt + t * QS + 8 * c8); }
        {   const int vv = tid % DV, vs = tid / DV;
#pragma unroll
            for (int i8 = 0; i8 < VLEN / 8; ++i8) { u32x4 pk; pk.x = ev[8 * i8] | ((unsigned)ev[8 * i8 + 1] << 16); pk.y = ev[8 * i8 + 2] | ((unsigned)ev[8 * i8 + 3] << 16);
                pk.z = ev[8 * i8 + 4] | ((unsigned)ev[8 * i8 + 5] << 16); pk.w = ev[8 * i8 + 6] | ((unsigned)ev[8 * i8 + 7] << 16);
                *(u32x4*)(vT + vv * TS + vs * VLEN + 8 * i8) = pk; } }
        lds_barrier();
        if (dir == 0) {
#pragma unroll
            for (int i = 0; i < DV / 64; ++i) { const int ci = tid + NTHREADS * i, vv = ci >> 3, c8 = ci & 7;
                *(u32x4*)(VTg + (size_t)bhc * (DV * 64) + vv * 64 + 8 * c8) = *(const u32x4*)(vT + vv * TS + 8 * c8); } }
        {   const int tt = w & 3, vg = (w >> 2) * (DV / 32);
            const bf16x8 y0 = *(const bf16x8*)(att + (16 * tt + fr) * TS + 8 * fq), y1 = *(const bf16x8*)(att + (16 * tt + fr) * TS + 32 + 8 * fq);
            bf16_t* op = c.O4() + (size_t)(dir * 2) * TT * D + (size_t)(r0 + 16 * tt + fr) * D + h * DV + 4 * fq;
#pragma unroll 4
            for (int v = 0; v < DV / 32; ++v) { const int vt = vg + v;
                const bf16x8 x0 = *(const bf16x8*)(vT + (16 * vt + fr) * TS + 8 * fq), x1 = *(const bf16x8*)(vT + (16 * vt + fr) * TS + 32 + 8 * fq);
                f32x4 o = mma16(x0, y0, (f32x4){0.f, 0.f, 0.f, 0.f}); o = mma16(x1, y1, o);
                u32x2 ww; ww.x = pack_bf2(o[0], o[1]); ww.y = pack_bf2(o[2], o[3]); *(u32x2*)(op + 16 * vt) = ww; } }
    }
#undef PREP_DECODE
#undef PREP_LOAD
}

template <int DK, int DV, int NH>
DI void scan_seq_phase(const Ctx& c, unsigned char* lds) {
    constexpr int QS = DK + 8, TS = 72, NCH = DK / 64, NDTW = DK / 128, NSL = DV / 64, NBHC = 4 * NH * 68;
    bf16_t* qt = (bf16_t*)lds;
    bf16_t* ktT = qt + 64 * QS;
    bf16_t* vTs = ktT + DK * TS;
    bf16_t* ST = vTs + 64 * TS;
    float* em = (float*)(ST + 64 * QS);
    const int tid = tidx(), lane = tid & 63, w = tid >> 6, fr = lane & 15, fq = lane >> 4;
    const bf16_t* QTg = (const bf16_t*)(c.ws + WS_PQT); const bf16_t* KTg = (const bf16_t*)(c.ws + WS_PKT); const bf16_t* VTg = (const bf16_t*)(c.ws + WS_PVT); const float* EMg = (const float*)(c.ws + WS_PEM);
    for (int cblk = blockIdx.x; cblk < 256; cblk += gridDim.x) {
        const int chain = (gridDim.x == 256) ? ((cblk & 7) * 32 + (cblk >> 3)) : cblk;
        const int sl = chain % NSL, dir = (chain / NSL) & 1, h = (chain / (2 * NSL)) % NH, b = chain / (2 * NSL * NH);
        f32x4 Sacc[NDTW][4];
#pragma unroll
        for (int i = 0; i < NDTW; ++i)
#pragma unroll
            for (int v = 0; v < 4; ++v) Sacc[i][v] = (f32x4){0.f, 0.f, 0.f, 0.f};
        u32x4 rqA[NCH], rkA[NCH], rvA, rqB[NCH], rkB[NCH], rvB; f32x4 reA = (f32x4){0.f, 0.f, 0.f, 0.f}, reB = reA;
#define SEQ_CIDX(n) (((n) < 4) ? (dir ? 3 - (n) : (n)) : 4 + (dir ? 63 - ((n) - 4) : ((n) - 4)))
#define SEQ_ROW0(ci) (((ci) < 4) ? (T + b * CL + 64 * (ci)) : (b * SEQ + 64 * ((ci) - 4)))
#define SEQ_LOAD(S_, n) do { const int ci_ = SEQ_CIDX(n), r0_ = SEQ_ROW0(ci_); const size_t bhc_ = (size_t)(b * NH + h) * 68 + ci_; \
            _Pragma("unroll") for (int i = 0; i < NCH; ++i) { const int cx = tid + NTHREADS * i; \
                rq##S_[i] = *(const u32x4*)(QTg + ((size_t)dir * TT + r0_ + cx / (DK / 8)) * (NH * DK) + h * DK + 8 * (cx % (DK / 8))); \
                rk##S_[i] = *(const u32x4*)(KTg + ((size_t)dir * NBHC + bhc_) * (DK * 64) + (size_t)cx * 8); } \
            rv##S_ = *(const u32x4*)(VTg + bhc_ * (DV * 64) + (size_t)(sl * 64) * 64 + (size_t)tidx() * 8);        \
            if (tid < DK / 2) re##S_ = *(const f32x4*)(EMg + ((size_t)dir * NBHC + bhc_) * (2 * DK) + 4 * tid); } while (0)
#define SEQ_STAGE(S_) do { \
            _Pragma("unroll") for (int i = 0; i < NCH; ++i) { const int cx = tid + NTHREADS * i; \
                *(u32x4*)(qt + (cx / (DK / 8)) * QS + 8 * (cx % (DK / 8))) = rq##S_[i]; *(u32x4*)(ktT + (cx >> 3) * TS + 8 * (cx & 7)) = rk##S_[i]; } \
            *(u32x4*)(vTs + (tid >> 3) * TS + 8 * (tid & 7)) = rv##S_; \
            if (tid < DK / 2) *(f32x4*)(em + 4 * tid) = re##S_; } while (0)
#define SEQ_STEP(n_) do { \
            const int r0 = SEQ_ROW0(SEQ_CIDX(n_)); const int tt = w & 3, vt0 = 2 * (w >> 2); \
            bf16_t* op = c.O4() + (size_t)(dir * 2 + 1) * TT * D + (size_t)(r0 + 16 * tt + fr) * D + h * DV + sl * 64 + 4 * fq; \
            _Pragma("unroll") for (int i = 0; i < NDTW; ++i) { const int dd = 16 * (w * NDTW + i) + fr; const float e1 = em[dd]; \
                _Pragma("unroll") for (int v = 0; v < 4; ++v) { Sacc[i][v] *= e1; \
                    _Pragma("unroll") for (int jj = 0; jj < 4; ++jj) ST[(16 * v + 4 * fq + jj) * QS + dd] = f2bf(Sacc[i][v][jj]); } } \
            lds_barrier(); \
            {   f32x4 o0 = (f32x4){0.f, 0.f, 0.f, 0.f}, o1 = o0; \
                _Pragma("unroll") for (int k0 = 0; k0 < DK; k0 += 32) { const bf16x8 y = *(const bf16x8*)(qt + (16 * tt + fr) * QS + k0 + 8 * fq); \
                    const bf16x8 x0 = *(const bf16x8*)(ST + (16 * vt0 + fr) * QS + k0 + 8 * fq), x1 = *(const bf16x8*)(ST + (16 * (vt0 + 1) + fr) * QS + k0 + 8 * fq); \
                    o0 = mma16(x0, y, o0); o1 = mma16(x1, y, o1); } \
                u32x2 w0, w1; w0.x = pack_bf2(o0[0], o0[1]); w0.y = pack_bf2(o0[2], o0[3]); w1.x = pack_bf2(o1[0], o1[1]); w1.y = pack_bf2(o1[2], o1[3]); \
                *(u32x2*)(op + 16 * vt0) = w0; *(u32x2*)(op + 16 * (vt0 + 1)) = w1; } \
            _Pragma("unroll") for (int i = 0; i < NDTW; ++i) { const int dt = w * NDTW + i; \
                _Pragma("unroll") for (int k0 = 0; k0 < 64; k0 += 32) { const bf16x8 y = *(const bf16x8*)(ktT + (16 * dt + fr) * TS + k0 + 8 * fq); \
                    _Pragma("unroll") for (int v = 0; v < 4; ++v) { const bf16x8 x = *(const bf16x8*)(vTs + (16 * v + fr) * TS + k0 + 8 * fq); Sacc[i][v] = mma16(x, y, Sacc[i][v]); } } \
                const float e2 = em[DK + 16 * dt + fr]; \
                _Pragma("unroll") for (int v = 0; v < 4; ++v) Sacc[i][v] *= e2; } \
            lds_barrier(); } while (0)
        SEQ_LOAD(A, 0); SEQ_LOAD(B, 1);
        lds_barrier();
        SEQ_STAGE(A);
        lds_barrier();
#pragma unroll 1
        for (int n = 0; n < 68; n += 2) {
            if (n + 2 < 68) SEQ_LOAD(A, n + 2);
            SEQ_STEP(n);
            SEQ_STAGE(B); lds_barrier();
            if (n + 3 < 68) SEQ_LOAD(B, n + 3);
            SEQ_STEP(n + 1);
            if (n + 2 < 68) { SEQ_STAGE(A); lds_barrier(); }
        }
#undef SEQ_STEP
#undef SEQ_CIDX
#undef SEQ_ROW0
#undef SEQ_LOAD
#undef SEQ_STAGE
    }
}

struct cpx { float re, im; };
DI cpx cmul(cpx a, cpx b) { return {a.re * b.re - a.im * b.im, a.re * b.im + a.im * b.re}; }
DI cpx cmulc(cpx a, cpx b) { return {a.re * b.re + a.im * b.im, a.im * b.re - a.re * b.im}; }
DI cpx cadd(cpx a, cpx b) { return {a.re + b.re, a.im + b.im}; }
DI cpx csub(cpx a, cpx b) { return {a.re - b.re, a.im - b.im}; }
DI int PADI(int i) { return i + 2 * (i >> 5); }
constexpr int FFT_N = 8192, FFT_NP = FFT_N + FFT_N / 16;
DI int brev4(int j) { return ((j & 1) << 3) | ((j & 2) << 1) | ((j & 4) >> 1) | ((j & 8) >> 3); }
DI cpx w16(int k) {
    const float c1 = 0.92387953251128674f, s1 = 0.38268343236508977f, h = 0.70710678118654752f;
    switch (k & 7) { case 0: return {1.f, 0.f}; case 1: return {c1, -s1}; case 2: return {h, -h}; case 3: return {s1, -c1}; case 4: return {0.f, -1.f}; case 5: return {-s1, -c1}; case 6: return {-h, -h}; default: return {-c1, -s1}; }
}
DI void dft16_dif(cpx (&v)[16]) {
#pragma unroll
    for (int s = 0; s < 4; ++s) { const int half = 8 >> s;
#pragma unroll
        for (int blk = 0; blk < 16; blk += 2 * half)
#pragma unroll
            for (int j = 0; j < half; ++j) { const cpx a = v[blk + j], b = v[blk + j + half]; v[blk + j] = cadd(a, b); const cpx dd = csub(a, b);
                v[blk + j + half] = (j == 0) ? dd : cmul(dd, w16(j * (8 / half))); } }
}
DI void dft16_dit_inv(cpx (&v)[16]) {
#pragma unroll
    for (int s = 3; s >= 0; --s) { const int half = 8 >> s;
#pragma unroll
        for (int blk = 0; blk < 16; blk += 2 * half)
#pragma unroll
            for (int j = 0; j < half; ++j) { const cpx a = v[blk + j]; const cpx b = (j == 0) ? v[blk + j + half] : cmulc(v[blk + j + half], w16(j * (8 / half)));
                v[blk + j] = cadd(a, b); v[blk + j + half] = csub(a, b); } }
}
template <int SP> DI void fft_fwd_pass_store(cpx (&v)[16], cpx* p, float th) {
    dft16_dif(v);
    th = pin_f(th);
    const cpx w1 = {cos_rev(th), -sin_rev(th)};
    cpx wp = w1;
    p[0] = v[0];
#pragma unroll
    for (int k1 = 1; k1 < 16; ++k1) { p[k1 * SP] = cmul(v[brev4(k1)], wp); if (k1 < 15) wp = cmul(wp, w1); }
}
template <int SP> DI void fft_load16(cpx (&v)[16], const cpx* p) {
#pragma unroll
    for (int n1 = 0; n1 < 16; ++n1) v[n1] = p[n1 * SP];
}
template <int SP> DI void fft_inv_pass_load(cpx (&v)[16], const cpx* p, float th) {
    th = pin_f(th);
    const cpx w1 = {cos_rev(th), -sin_rev(th)};
    cpx wp = w1;
    v[0] = p[0];
#pragma unroll
    for (int k1 = 1; k1 < 16; ++k1) { v[brev4(k1)] = cmulc(p[k1 * SP], wp); if (k1 < 15) wp = cmul(wp, w1); }
    dft16_dit_inv(v);
}
template <int SP> DI void fft_store16(const cpx (&v)[16], cpx* p) {
#pragma unroll
    for (int n1 = 0; n1 < 16; ++n1) p[n1 * SP] = v[n1];
}
DI void fft_forward(cpx (&v)[16], cpx* buf, bool last_pair_pass) {
    const int tid = tidx();
    fft_fwd_pass_store<544>(v, buf + PADI(tid), (float)tid * (1.0f / 8192.0f));
    __syncthreads();
    { cpx* p = buf + PADI((tid >> 5) * 512 + (tid & 31)); fft_load16<34>(v, p); fft_fwd_pass_store<34>(v, p, (float)(tid & 31) * (1.0f / 512.0f)); }
    __syncthreads();
    { cpx* p = buf + PADI((tid >> 1) * 32 + (tid & 1)); fft_load16<2>(v, p); fft_fwd_pass_store<2>(v, p, (float)(tid & 1) * (1.0f / 32.0f)); }
    __syncthreads();
    if (last_pair_pass) {
        cpx* p = buf + PADI(2 * tid);
#pragma unroll
        for (int jx = 0; jx < 8; ++jx) { const cpx a = p[jx * 1088], b = p[jx * 1088 + 1]; p[jx * 1088] = cadd(a, b); p[jx * 1088 + 1] = csub(a, b); }
        __syncthreads();
    }
}
DI void fft_mul_inverse(cpx (&v)[16], cpx* A, const cpx* Hs) {
    const int tid = tidx();
    {   cpx* p = A + PADI(2 * tid); const cpx* hp = Hs + PADI(2 * tid);
#pragma unroll
        for (int jx = 0; jx < 8; ++jx) { const cpx a = p[jx * 1088], b = p[jx * 1088 + 1];
            const cpx P = cmul(cadd(a, b), hp[jx * 1088]), Q = cmul(csub(a, b), hp[jx * 1088 + 1]); p[jx * 1088] = cadd(P, Q); p[jx * 1088 + 1] = csub(P, Q); } }
    __syncthreads();
    { cpx* p = A + PADI((tid >> 1) * 32 + (tid & 1)); fft_inv_pass_load<2>(v, p, (float)(tid & 1) * (1.0f / 32.0f)); fft_store16<2>(v, p); }
    __syncthreads();
    { cpx* p = A + PADI((tid >> 5) * 512 + (tid & 31)); fft_inv_pass_load<34>(v, p, (float)(tid & 31) * (1.0f / 512.0f)); fft_store16<34>(v, p); }
    __syncthreads();
    fft_inv_pass_load<544>(v, A + PADI(tid), (float)tid * (1.0f / 8192.0f));
    __syncthreads();
}
template <int SP> DI void fft2_fwd_pass_store(cpx (&v0)[16], cpx (&v1)[16], cpx* p0, cpx* p1, float th) {
    dft16_dif(v0); dft16_dif(v1);
    th = pin_f(th);
    const cpx w1 = {cos_rev(th), -sin_rev(th)};
    cpx wp = w1;
    p0[0] = v0[0]; p1[0] = v1[0];
#pragma unroll
    for (int k1 = 1; k1 < 16; ++k1) { p0[k1 * SP] = cmul(v0[brev4(k1)], wp); p1[k1 * SP] = cmul(v1[brev4(k1)], wp); if (k1 < 15) wp = cmul(wp, w1); }
}
template <int SP> DI void fft2_inv_pass_load(cpx (&v0)[16], cpx (&v1)[16], const cpx* p0, const cpx* p1, float th) {
    th = pin_f(th);
    const cpx w1 = {cos_rev(th), -sin_rev(th)};
    cpx wp = w1;
    v0[0] = p0[0]; v1[0] = p1[0];
#pragma unroll
    for (int k1 = 1; k1 < 16; ++k1) { v0[brev4(k1)] = cmulc(p0[k1 * SP], wp); v1[brev4(k1)] = cmulc(p1[k1 * SP], wp); if (k1 < 15) wp = cmul(wp, w1); }
    dft16_dit_inv(v0); dft16_dit_inv(v1);
}
DI cpx cpx_swap(cpx v) { return {lane_xor1(v.re), lane_xor1(v.im)}; }
DI void fft_filter(cpx (&v)[16], cpx* buf, cpx (&H)[16]) {
    const int tid = tidx();
    fft_fwd_pass_store<544>(v, buf + PADI(tid), (float)tid * (1.0f / 8192.0f));
    lds_barrier();
    { cpx* p = buf + PADI((tid >> 5) * 512 + (tid & 31)); fft_load16<34>(v, p); fft_fwd_pass_store<34>(v, p, (float)(tid & 31) * (1.0f / 512.0f)); }
    lds_barrier();
    fft_load16<2>(v, buf + PADI((tid >> 1) * 32 + (tid & 1)));
    dft16_dif(v);
    const float sgn = (tid & 1) ? -1.0f : 1.0f; const float th = pin_f((float)(tid & 1) * (1.0f / 32.0f));
    const cpx w1 = {cos_rev(th), -sin_rev(th)}; cpx wp = w1;
#pragma unroll
    for (int k1 = 0; k1 < 16; ++k1) { cpx y = v[brev4(k1)]; if (k1 > 0) { y = cmul(y, wp); if (k1 < 15) wp = cmul(wp, w1); }
        const cpx o = cpx_swap(y); H[k1] = {o.re + sgn * y.re, o.im + sgn * y.im}; }
    lds_barrier();
}
DI void fft2_conv(cpx (&v0)[16], cpx (&v1)[16], cpx* A0, cpx* A1, const cpx (&H)[16]) {
    const int tid = tidx();
    {   const int o = PADI(tid); fft2_fwd_pass_store<544>(v0, v1, A0 + o, A1 + o, (float)tid * (1.0f / 8192.0f)); }
    lds_barrier();
    {   const int o = PADI((tid >> 5) * 512 + (tid & 31)); fft_load16<34>(v0, A0 + o); fft_load16<34>(v1, A1 + o); fft2_fwd_pass_store<34>(v0, v1, A0 + o, A1 + o, (float)(tid & 31) * (1.0f / 512.0f)); }
    lds_barrier();
    {   const int o = PADI((tid >> 1) * 32 + (tid & 1)); fft_load16<2>(v0, A0 + o); fft_load16<2>(v1, A1 + o);
        dft16_dif(v0); dft16_dif(v1);
        const float sgn = (tid & 1) ? -1.0f : 1.0f; const float th = pin_f((float)(tid & 1) * (1.0f / 32.0f));
        const cpx w1 = {cos_rev(th), -sin_rev(th)}; cpx wp = w1;
#pragma unroll
        for (int k1 = 0; k1 < 16; ++k1) { cpx y0 = v0[brev4(k1)], y1 = v1[brev4(k1)];
            if (k1 > 0) { y0 = cmul(y0, wp); y1 = cmul(y1, wp); }
            const cpx o0 = cpx_swap(y0), o1 = cpx_swap(y1);
            const cpx R0 = cmul((cpx){o0.re + sgn * y0.re, o0.im + sgn * y0.im}, H[k1]), R1 = cmul((cpx){o1.re + sgn * y1.re, o1.im + sgn * y1.im}, H[k1]);
            const cpx q0 = cpx_swap(R0), q1 = cpx_swap(R1);
            cpx z0 = {q0.re + sgn * R0.re, q0.im + sgn * R0.im}, z1 = {q1.re + sgn * R1.re, q1.im + sgn * R1.im};
            if (k1 > 0) { z0 = cmulc(z0, wp); z1 = cmulc(z1, wp); if (k1 < 15) wp = cmul(wp, w1); }
            PIN4(z0.re, z0.im, z1.re, z1.im);
            v0[brev4(k1)] = z0; v1[brev4(k1)] = z1; }
        dft16_dit_inv(v0); dft16_dit_inv(v1);
        fft_store16<2>(v0, A0 + o); fft_store16<2>(v1, A1 + o); }
    lds_barrier();
    {   const int o = PADI((tid >> 5) * 512 + (tid & 31)); fft2_inv_pass_load<34>(v0, v1, A0 + o, A1 + o, (float)(tid & 31) * (1.0f / 512.0f)); fft_store16<34>(v0, A0 + o); fft_store16<34>(v1, A1 + o); }
    lds_barrier();
    {   const int o = PADI(tid); fft2_inv_pass_load<544>(v0, v1, A0 + o, A1 + o, (float)tid * (1.0f / 8192.0f)); }
    lds_barrier();
}
DI float conv3_at(const bf16_t* row, int pos, int W, float w0, float w1, float w2) {
    const int cc = pos & (W - 1);
    const float u0 = cc > 0 ? bf2f(row[pos - 1]) : 0.f, u1 = bf2f(row[pos]), u2 = cc < W - 1 ? bf2f(row[pos + 1]) : 0.f;
    return w0 * u0 + w1 * u1 + w2 * u2;
}
DI float conv3_wave(const bf16_t* row, int pos, float w0, float w1, float w2) {
    const float u1 = bf2f(row[pos]);
    return w0 * lane_prev(u1) + w1 * u1 + w2 * lane_next(u1);
}
DI float block_sum_lds(float v, float* red  ) {
    v = wave_sum(v);
    lds_barrier();
    { const int t_ = tidx(); if ((t_ & 63) == 0) red[t_ >> 6] = v; }
    lds_barrier();
    float s = 0.f;
#pragma unroll
    for (int i = 0; i < 8; ++i) s += red[i];
    return s;
}
DI float block_sum(float v, float* red  ) {
    v = wave_sum(v);
    __syncthreads();
    { const int t_ = tidx(); if ((t_ & 63) == 0) red[t_ >> 6] = v; }
    __syncthreads();
    float s = 0.f;
#pragma unroll
    for (int i = 0; i < 8; ++i) s += red[i];
    return s;
}
constexpr float HY_DMIN = -3.0701134573253945f, HY_DMAX = -15.350567286626973f;

DI void hyena_conv_phase(const Ctx& c, int jl, bool need_ctx, unsigned char* lds) {
    cpx* A = (cpx*)lds; cpx* B = A + FFT_NP;
    float* fwc = (float*)(B + FFT_NP);
    float* red = fwc + 256;
    const int tid = tidx();
    const bf16_t* UT = c.U(); bf16_t* Z2 = c.Z2T();
    const float* fwout = c.in[18] + (size_t)jl * 64 * (4 * D);
    const float* cw = c.in[12] + (size_t)jl * 3 * HY_N;
    const float* hid2 = c.HID2L(jl);
    float* scr = (float*)(c.ws + WS_HYS + (size_t)(blockIdx.x & 255) * HYS_PER_BLOCK);
    float* hts = (float*)(c.ws + WS_HTS) + (size_t)(blockIdx.x & 255) * (8 * 4 * SEQ);
    {   bf16_t* fwh = (bf16_t*)lds;
        bf16_t* fwl = fwh + 32 * 72;
        float* dl = (float*)(fwl + 32 * 72);
        const int lane = tid & 63, w = tid >> 6, fr = lane & 15, fq = lane >> 4;
        __syncthreads();
        for (int idx = tid; idx < 32 * 64; idx += NTHREADS) { const int col = idx >> 6, j = idx & 63, k = col >> 2, q = col & 3; const int ch = blockIdx.x + k * gridDim.x;
            const float wv = ch < D ? fwout[(size_t)j * (4 * D) + q * D + ch] : 0.f; const bf16_t hi = f2bf(wv);
            fwh[col * 72 + j] = hi; fwl[col * 72 + j] = f2bf(wv - bf2f(hi)); }
        if (tid < 8) { const int ch = blockIdx.x + tid * gridDim.x; dl[tid] = fabsf(HY_DMIN + (HY_DMAX - HY_DMIN) * (float)ch / (float)(D - 1)); }
        __syncthreads();
        bf16x8 bh[2][2], bl[2][2];
#pragma unroll
        for (int ct = 0; ct < 2; ++ct)
#pragma unroll
            for (int s2 = 0; s2 < 2; ++s2) { bh[ct][s2] = *(const bf16x8*)(fwh + (16 * ct + fr) * 72 + 32 * s2 + 8 * fq); bl[ct][s2] = *(const bf16x8*)(fwl + (16 * ct + fr) * 72 + 32 * s2 + 8 * fq); }
        constexpr int NIT = SEQ / 16 / 8;
        f32x4 xb[4][4];
#define P1_LOAD(j_, it_) do { const float* hr_ = hid2 + (size_t)(16 * (w + 8 * (it_)) + fr) * 64 + 8 * fq; \
            xb[j_][0] = *(const f32x4*)(hr_); xb[j_][1] = *(const f32x4*)(hr_ + 4); xb[j_][2] = *(const f32x4*)(hr_ + 32); xb[j_][3] = *(const f32x4*)(hr_ + 36); } while (0)
#pragma unroll
        for (int j = 0; j < 4; ++j) P1_LOAD(j, j);
#pragma unroll 1
        for (int it = 0; it < NIT; it += 4) {
#pragma unroll
            for (int j = 0; j < 4; ++j) { const int p0 = 16 * (w + 8 * (it + j));
                const f32x4 xa[4] = {xb[j][0], xb[j][1], xb[j][2], xb[j][3]};
                if (it + 4 < NIT) P1_LOAD(j, it + j + 4);
                bf16x8 ah[2], al[2];
#pragma unroll
                for (int s2 = 0; s2 < 2; ++s2) { const f32x4 x0 = xa[2 * s2], x1 = xa[2 * s2 + 1]; u32x4 ph, pl;
                    ph.x = pack_bf2(x0[0], x0[1]); ph.y = pack_bf2(x0[2], x0[3]); ph.z = pack_bf2(x1[0], x1[1]); ph.w = pack_bf2(x1[2], x1[3]);
                    pl.x = pack_bf2(x0[0] - u_as_f(ph.x << 16), x0[1] - u_as_f(ph.x & 0xffff0000u)); pl.y = pack_bf2(x0[2] - u_as_f(ph.y << 16), x0[3] - u_as_f(ph.y & 0xffff0000u));
                    pl.z = pack_bf2(x1[0] - u_as_f(ph.z << 16), x1[1] - u_as_f(ph.z & 0xffff0000u)); pl.w = pack_bf2(x1[2] - u_as_f(ph.w << 16), x1[3] - u_as_f(ph.w & 0xffff0000u));
                    ah[s2] = __builtin_bit_cast(bf16x8, ph); al[s2] = __builtin_bit_cast(bf16x8, pl); }
#pragma unroll
                for (int ct = 0; ct < 2; ++ct) { f32x4 acc = (f32x4){0.f, 0.f, 0.f, 0.f};
#pragma unroll
                    for (int s2 = 0; s2 < 2; ++s2) { acc = mma16(ah[s2], bh[ct][s2], acc); acc = mma16(ah[s2], bl[ct][s2], acc); acc = mma16(al[s2], bh[ct][s2], acc); }
                    const int col = 16 * ct + fr, k = col >> 2; const float ck = dl[k] * (-LOG2E / (float)(SEQ - 1)); const int pb = p0 + 4 * fq;
                    f32x4 o;
#pragma unroll
                    for (int jj = 0; jj < 4; ++jj) o[jj] = acc[jj] * fexp2((float)(pb + jj) * ck);
                    *(f32x4*)(hts + (size_t)col * SEQ + pb) = o; } } }
#undef P1_LOAD
        __syncthreads();
    }
    float hv[16];
#define HK_LOAD(hkp_, ord_, t_) do { const float* hf_ = (hkp_) + (size_t)(ord_) * SEQ; const float* hb_ = (hkp_) + (size_t)(2 + (ord_)) * SEQ; \
        _Pragma("unroll") for (int n1 = 0; n1 < 16; ++n1) { const int n_ = n1 * 512 + (t_); hv[n1] = n1 < 8 ? hf_[n_] : hb_[2 * SEQ - 1 - n_]; } } while (0)
    HK_LOAD(hts, 0, tid);
    int kidx = 0;
    for (int ch = blockIdx.x; ch < D; ch += gridDim.x, ++kidx) {
        const float* hk = hts + (size_t)kidx * (4 * SEQ);
        __syncthreads();
        if (need_ctx && tid < 256) fwc[tid] = fwout[(size_t)(tid & 63) * (4 * D) + (tid >> 6) * D + ch];
        const float delta = fabsf(HY_DMIN + (HY_DMAX - HY_DMIN) * (float)ch / (float)(D - 1));
        const float skip1 = c.in[19][((size_t)jl * 2 + 0) * D + ch], skip2 = c.in[19][((size_t)jl * 2 + 1) * D + ch];
        float tw[3][3];
#pragma unroll
        for (int s = 0; s < 3; ++s)
#pragma unroll
            for (int k = 0; k < 3; ++k) tw[s][k] = cw[(size_t)k * HY_N + s * D + ch];
#pragma unroll 1
        for (int order = 0; order < 2; ++order) {
            const int tq = tidx();
            cpx H[16];
            {   cpx v[16]; float sa = 0.f;
#pragma unroll
                for (int n1 = 0; n1 < 16; ++n1) { const float f = (n1 == 8 && tq == 0) ? 0.f : hv[n1];
                    sa += fabsf(f); v[n1] = {f, 0.f}; }
                sa = block_sum_lds(sa, red);
                const float sc = 1.0f / (sa * 8192.0f);
#pragma unroll
                for (int n1 = 0; n1 < 16; ++n1) v[n1].re *= sc;
                fft_filter(v, A, H); }
            const float skip = order ? skip2 : skip1;
            const float gw0 = order ? tw[2][0] : tw[1][0], gw1 = order ? tw[2][1] : tw[1][1], gw2 = order ? tw[2][2] : tw[1][2];
            const bf16_t* rb = UT + (size_t)ch * TT;
            cpx v0[16], v1[16];
            if (order == 0) {
#pragma unroll
                for (int n1 = 0; n1 < 8; ++n1) { const int pos = n1 * 512 + tq;
                    v0[n1] = {conv3_wave(rb, pos, tw[0][0], tw[0][1], tw[0][2]), conv3_wave(rb + SEQ, pos, tw[0][0], tw[0][1], tw[0][2])};
                    v1[n1] = {conv3_wave(rb + 2 * SEQ, pos, tw[0][0], tw[0][1], tw[0][2]), conv3_wave(rb + 3 * SEQ, pos, tw[0][0], tw[0][1], tw[0][2])};
                    scr[(4 * n1) * 512 + tq] = v0[n1].re; scr[(4 * n1 + 1) * 512 + tq] = v0[n1].im; scr[(4 * n1 + 2) * 512 + tq] = v1[n1].re; scr[(4 * n1 + 3) * 512 + tq] = v1[n1].im; }
            } else {
#pragma unroll
                for (int n1 = 0; n1 < 8; ++n1) { v0[n1] = {scr[(4 * n1) * 512 + tq], scr[(4 * n1 + 1) * 512 + tq]}; v1[n1] = {scr[(4 * n1 + 2) * 512 + tq], scr[(4 * n1 + 3) * 512 + tq]}; }
            }
#pragma unroll
            for (int n1 = 8; n1 < 16; ++n1) { v0[n1] = {0.f, 0.f}; v1[n1] = {0.f, 0.f}; }
            fft2_conv(v0, v1, A, B, H);
            const int te = tidx();
            const bf16_t* gb = UT + (size_t)((order + 1) * D + ch) * TT;
            {   const bool lastc = ch + (int)gridDim.x >= D; const float* hkn = (order == 0 || lastc) ? hk : hk + 4 * SEQ; const int on = (order == 0) ? 1 : (lastc ? 1 : 0);
                HK_LOAD(hkn, on, te); }
#pragma unroll
            for (int hh = 0; hh < 2; ++hh) { float u[4][4]; bf16_t gr[4][4];
#pragma unroll
                for (int q = 0; q < 4; ++q) { const int n1 = hh * 4 + q, pos = n1 * 512 + te;
#pragma unroll
                    for (int b = 0; b < 4; ++b) { u[q][b] = scr[(4 * n1 + b) * 512 + te];
                        gr[q][b] = gb[(size_t)b * SEQ + pos]; } }
                MEM_FENCE();
#pragma unroll
                for (int q = 0; q < 4; ++q) { const int n1 = hh * 4 + q;
                    const float cv[4] = {v0[n1].re, v0[n1].im, v1[n1].re, v1[n1].im};
#pragma unroll
                    for (int b = 0; b < 4; ++b) { const float g1 = bf2f(gr[q][b]); u[q][b] = (gw0 * lane_prev(g1) + gw1 * g1 + gw2 * lane_next(g1)) * (cv[b] + skip * u[q][b]); } }
                if (order == 0) {
#pragma unroll
                    for (int q = 0; q < 4; ++q)
#pragma unroll
                        for (int b = 0; b < 4; ++b) scr[(4 * (hh * 4 + q) + b) * 512 + te] = u[q][b];
                } else {
#pragma unroll
                    for (int q = 0; q < 4; ++q)
#pragma unroll
                        for (int b = 0; b < 4; ++b) Z2[(size_t)ch * TT + (size_t)b * SEQ + (hh * 4 + q) * 512 + te] = f2bf(u[q][b]);
                }
                MEM_FENCE(); }
        }
        if (need_ctx) {
            float* gs = (float*)lds;
            float* uv = gs + 2 * 544;
            float* ux1 = uv + 1024;
            float* ux2 = ux1 + 1024;
            float* zz = ux2 + 1024;
            float* hq = zz + 1024;
            float* part = hq + 1024;
            __syncthreads();
            {   const int p = tid & 255, qh = tid >> 8; const float* hr = c.HID2C(jl) + (size_t)p * 64; float a0 = 0.f, a1 = 0.f;
                f32x4 hv[16];
#pragma unroll
                for (int j = 0; j < 16; ++j) hv[j] = *(const f32x4*)(hr + 4 * j);
#pragma unroll
                for (int j = 0; j < 16; ++j) { const f32x4 fa = *(const f32x4*)(fwc + (2 * qh) * 64 + 4 * j), fb = *(const f32x4*)(fwc + (2 * qh + 1) * 64 + 4 * j);
#pragma unroll
                    for (int e = 0; e < 4; ++e) { a0 += hv[j][e] * fa[e]; a1 += hv[j][e] * fb[e]; } }
                const float dec = expf(-((float)p / (float)(CL - 1)) * delta);
                hq[(2 * qh) * 256 + p] = a0 * dec; hq[(2 * qh + 1) * 256 + p] = a1 * dec; }
            {   bf16_t raw[2][3][3];
#pragma unroll
                for (int k = 0; k < 2; ++k) { const int i = tid + k * NTHREADS, b = i >> 8, p = i & 255; const int pl = p > 0 ? p - 1 : p, pr = p < 255 ? p + 1 : p;
#pragma unroll
                    for (int s3 = 0; s3 < 3; ++s3) { const bf16_t* r = UT + (size_t)(s3 * D + ch) * TT + T + b * CL; raw[k][s3][0] = r[pl]; raw[k][s3][1] = r[p]; raw[k][s3][2] = r[pr]; } }
#pragma unroll
                for (int k = 0; k < 2; ++k) { const int i = tid + k * NTHREADS, p = i & 255; float o[3];
#pragma unroll
                    for (int s3 = 0; s3 < 3; ++s3) o[s3] = tw[s3][0] * (p > 0 ? bf2f(raw[k][s3][0]) : 0.f) + tw[s3][1] * bf2f(raw[k][s3][1]) + tw[s3][2] * (p < 255 ? bf2f(raw[k][s3][2]) : 0.f);
                    uv[i] = o[0]; ux1[i] = o[1]; ux2[i] = o[2]; } }
            __syncthreads();
            float s0 = 0.f, s1 = 0.f;
            if (tid < 256) { s0 = fabsf(hq[tid]) + (tid < 255 ? fabsf(hq[512 + tid]) : 0.f); s1 = fabsf(hq[256 + tid]) + (tid < 255 ? fabsf(hq[768 + tid]) : 0.f); }
            s0 = block_sum(s0, red); s1 = block_sum(s1, red);
            for (int i = tid; i < 2 * 544; i += NTHREADS) { const int order = i / 544, m = i % 544, n = (m + 249) & 511; float f;
                if (n < 256) f = hq[order * 256 + n]; else if (n == 256) f = 0.f; else f = hq[(2 + order) * 256 + (511 - n)];
                gs[i] = f / (order ? s1 : s0); }
            __syncthreads();
            const int og = tid & 127, sg = tid >> 7, cb = og >> 5, t0 = (og & 31) * 8;
#pragma unroll 1
            for (int order = 0; order < 2; ++order) {
                const float* src = (order ? zz : uv) + cb * 256; const float* gp = gs + order * 544;
                float acc[8];
#pragma unroll
                for (int j = 0; j < 8; ++j) acc[j] = 0.f;
#pragma unroll 2
                for (int s8 = 0; s8 < 8; ++s8) { const int sb = 64 * sg + 8 * s8;
                    const f32x4* wq = (const f32x4*)(gp + t0 - sb + 256); const f32x4 w0 = wq[0], w1 = wq[1], w2 = wq[2], w3 = wq[3];
                    const f32x4 ua = *(const f32x4*)(src + sb), ub = *(const f32x4*)(src + sb + 4);
                    const float W[16] = {w0[0], w0[1], w0[2], w0[3], w1[0], w1[1], w1[2], w1[3], w2[0], w2[1], w2[2], w2[3], w3[0], w3[1], w3[2], w3[3]};
                    const float U[8] = {ua[0], ua[1], ua[2], ua[3], ub[0], ub[1], ub[2], ub[3]};
#pragma unroll
                    for (int u = 0; u < 8; ++u)
#pragma unroll
                        for (int j = 0; j < 8; ++j) acc[j] += W[7 + j - u] * U[u]; }
                *(f32x4*)(part + (sg * 128 + og) * 8) = (f32x4){acc[0], acc[1], acc[2], acc[3]}; *(f32x4*)(part + (sg * 128 + og) * 8 + 4) = (f32x4){acc[4], acc[5], acc[6], acc[7]};
                __syncthreads();
                for (int i = tid; i < 1024; i += NTHREADS) { const int g2 = i >> 3, j = i & 7;
                    const float y = (part[g2 * 8 + j] + part[(128 + g2) * 8 + j]) + (part[(256 + g2) * 8 + j] + part[(384 + g2) * 8 + j]);
                    if (order == 0) zz[i] = ux1[i] * (y + skip1 * uv[i]);
                    else Z2[(size_t)ch * TT + T + (i >> 8) * CL + (i & 255)] = f2bf(ux2[i] * (y + skip2 * zz[i])); }
                __syncthreads();
            }
        }
    }
}

#undef HK_LOAD
#ifndef HOST_EMU
struct Args { const float* in[30]; float* out; unsigned char* ws; int ph_lo, ph_hi; };
constexpr int PH_PER_LAYER = 9;
constexpr int N_PHASES = 2 + PH_PER_LAYER * DEPTH;

__global__ void __launch_bounds__(NTHREADS, 2) fwd_kernel(Args args) {
    extern __shared__ __attribute__((aligned(16))) unsigned char lds[];
    Ctx c;
#pragma unroll
    for (int i = 0; i < 30; ++i) c.in[i] = args.in[i];
    c.out = args.out; c.ws = args.ws;
    const int lo = args.ph_lo, hi = args.ph_hi;
    volatile LAS unsigned* bst = (volatile LAS unsigned*)((LAS unsigned char*)lds + LDS_BAR_OFF);
    XcdBarrier bar; bar.bar = (unsigned*)(args.ws + WS_CTL); bar.x = 0; bar.st = bst;
    if (!MK_PER_PHASE) {
        if (threadIdx.x == 0) { bst[0] = 0u; bst[1] = 0u; bst[2] = 0u; bst[3] = 0u; }
        __syncthreads();
        bar = xcd_barrier_post((unsigned*)(args.ws + WS_CTL), bst);
    }
#define IN(k) (lo <= (k) && (k) < hi)
#define SEAM(k) do { if (IN(k) && IN((k) + 1)) xcd_barrier(bar); } while (0)
    LAS unsigned char* glds = (LAS unsigned char*)lds;
    const int G = (int)gridDim.x, bid = (int)blockIdx.x;

    if (DBG(0) && IN(0)) { _Pragma("unroll 1") for (int rep_ = 0; rep_ < REPS(0); ++rep_) prologue_phase(c, lds); }
    SEAM(0);
#pragma unroll 1
    for (int l = 0; l < DEPTH; ++l) {
        const int base = 1 + PH_PER_LAYER * l, kind = l % 3, j = l / 3;
        const bool last = (l == DEPTH - 1);
        const bool need_ctx = !last || kind != 0;
        const int rows = need_ctx ? TT : T;
        float* modv = c.MODV(l);
        const bool ctx_ffn = l < 2;
        float* P1 = c.O2();
        float* P2 = c.O2() + (size_t)8 * TC * D;
        if (DBG(1) && IN(base + 0)) {
            const float* pg_ = c.MODV(l > 0 ? l - 1 : 0) + (size_t)NBATCH * NMOD * D + 5 * D;
            if (l == 0) norm_mod_phase<true, true>(c.in[0], c.in[2], c.X() + (size_t)T * D, c.in[6] + (size_t)l * D, modv, 0, 1, c.HN(), rows, P2, 0, pg_);
            else norm_mod_phase<false, false>(c.X(), c.X() + (size_t)T * D, c.X() + (size_t)T * D, c.in[6] + (size_t)l * D, modv, 0, 1, c.HN(), rows, P2, (l == 1 || l == 2) ? 4 : 0, pg_); }
        SEAM(base + 0);
        if (IN(base + 1)) _Pragma("unroll 1") for (int rep_ = 0; rep_ < REPS(2); ++rep_) {
            if (DBG(2) && kind == 0) {
                pg8::Gemm g{(const bf16_t*)(c.ws + WS_WHYIN) + (size_t)j * HY_N * D, c.HN(), HY_N, rows, D, D}; pg8::StaticOrder S; S.init(HY_N, rows, G, bid);
                EpiStoreBf16 E{c.U(), TT};
                pg8::gemm_phase<EpiStoreBf16, pg8::StaticOrder>(glds, g, S, E);
            } else if (DBG(3) && kind == 1) {
                pg8::Gemm g{c.HN(), (const bf16_t*)(c.ws + WS_WHGIN), rows, HG_N, D, D}; pg8::StaticOrder S; S.init(rows, HG_N, G, bid);
                EpiHgIn E{c.U(), c.LB()};
                pg8::gemm_phase<EpiHgIn, pg8::StaticOrder>(glds, g, S, E);
            } else if (DBG(4) && kind == 2) {
                pg8::Gemm g{c.HN(), (const bf16_t*)(c.ws + WS_WGLIN), rows, GLA_NP, D, D}; pg8::StaticOrder S; S.init(rows, GLA_NP, G, bid);
                EpiGlaIn E{c.U(), c.GA()};
                pg8::gemm_phase<EpiGlaIn, pg8::StaticOrder>(glds, g, S, E);
            }
        }
        if (IN(base + 1) && G == 256 && l + 1 < DEPTH && idle_a(l) > 0 && bid >= 256 - idle_a(l)) convert_layer(c, l + 1, 0, slot_a_end(l + 1), bid - (256 - idle_a(l)), idle_a(l), (float*)lds);
        SEAM(base + 1);
        if (IN(base + 2)) {
            if (DBG(5) && kind == 0) _Pragma("unroll 1") for (int rep_ = 0; rep_ < REPS(3); ++rep_) hyena_conv_phase(c, j, need_ctx, lds);
            else if (DBG(6) && kind == 1) _Pragma("unroll 1") for (int rep_ = 0; rep_ < REPS(4); ++rep_) scan_prep_phase<128, 128, 16, false>(c, lds);
            else if (DBG(7) && kind == 2) _Pragma("unroll 1") for (int rep_ = 0; rep_ < REPS(4); ++rep_) scan_prep_phase<256, 512, 4, true>(c, lds);
        }
        SEAM(base + 2);
        if (IN(base + 3)) {
            if (DBG(13) && kind == 1) scan_seq_phase<128, 128, 16>(c, lds);
            else if (DBG(14) && kind == 2) scan_seq_phase<256, 512, 4>(c, lds);
        }
        if (kind != 0) SEAM(base + 3);
        if (IN(base + 4)) _Pragma("unroll 1") for (int rep_ = 0; rep_ < REPS(1); ++rep_) {
            if (DBG(8) && kind == 0) transpose_z_phase(c.Z2T(), c.HN(), rows, lds);
            else if (DBG(8) && kind == 1) headnorm_phase<128>(c.O4(), c.in[23] + (size_t)j * D, c.U(), HG_N, 4096, c.HN(), rows);
            else if (DBG(8) && kind == 2) headnorm_phase<512>(c.O4(), c.in[28] + (size_t)j * D, c.U(), GLA_NV, 4096, c.HN(), rows);
        }
        SEAM(base + 4);
        if (DBG(9) && IN(base + 5)) {
            const bf16_t* wt = kind == 0 ? (const bf16_t*)(c.ws + WS_WHYOUT) + (size_t)j * D * D : (kind == 1 ? (const bf16_t*)(c.ws + WS_WHGOUT) : (const bf16_t*)(c.ws + WS_WGLOUT));
            {   pg8::Gemm g{c.HN(), wt, T, D, D, D}; pg8::StaticOrder S; S.init(T, D, G, bid);
                if (l == 0) { EpiResid<true> E{c.in[0], c.X(), modv + 2 * D};
                    pg8::gemm_phase<EpiResid<true>, pg8::StaticOrder>(glds, g, S, E); }
                else { EpiResid<false> E{c.X(), c.X(), modv + 2 * D};
                    pg8::gemm_phase<EpiResid<false>, pg8::StaticOrder>(glds, g, S, E); } }
            if (ctx_ffn) {
                pg8::Gemm g{c.HN() + (size_t)T * D, wt, TC, D, D / 8, D}; pg8::SplitKOrder S; S.init(TC, D, 8, G, bid);
                EpiPartial E{P1};
                pg8::gemm_phase<EpiPartial, pg8::SplitKOrder>(glds, g, S, E); }
        }
        SEAM(base + 5);
        const int frows = ctx_ffn ? TT : T;
        if (DBG(1) && IN(base + 6)) {
            if (l == 0) norm_mod_phase<false, true>(c.X(), c.in[2], c.X() + (size_t)T * D, c.in[7] + (size_t)l * D, modv, 3, 4, c.HN(), frows, P1, ctx_ffn ? 8 : 0, modv + (size_t)NBATCH * NMOD * D + 2 * D);
            else norm_mod_phase<false, false>(c.X(), c.X() + (size_t)T * D, c.X() + (size_t)T * D, c.in[7] + (size_t)l * D, modv, 3, 4, c.HN(), frows, P1, ctx_ffn ? 8 : 0, modv + (size_t)NBATCH * NMOD * D + 2 * D); }
        SEAM(base + 6);
        if (DBG(10) && IN(base + 7)) _Pragma("unroll 1") for (int rep_ = 0; rep_ < REPS(6); ++rep_) {
            pg8::Gemm g{c.HN(), (const bf16_t*)(c.ws + WS_WFIN) + (size_t)l * 2 * FF * D, frows, 2 * FF, D, D}; pg8::StaticOrder S; S.init(frows, 2 * FF, G, bid);
            EpiSwiGLU E{c.U()};
            pg8::gemm_phase<EpiSwiGLU, pg8::StaticOrder>(glds, g, S, E);
        }
        if (IN(base + 7) && G == 256 && l + 1 < DEPTH && idle_b(l) > 0 && bid >= 256 - idle_b(l)) convert_layer(c, l + 1, slot_a_end(l + 1), slot_b_end(l + 1), bid - (256 - idle_b(l)), idle_b(l), (float*)lds);
        SEAM(base + 7);
        if (DBG(11) && IN(base + 8)) {
            const bf16_t* wt = (const bf16_t*)(c.ws + WS_WFOUT) + (size_t)l * D * FF;
            {   pg8::Gemm g{c.U(), wt, T, D, FF, FF}; pg8::StaticOrder S; S.init(T, D, G, bid);
                EpiResid<false> E{c.X(), c.X(), modv + 5 * D};
                pg8::gemm_phase<EpiResid<false>, pg8::StaticOrder>(glds, g, S, E); }
            if (ctx_ffn) {
                pg8::Gemm g{c.U() + (size_t)T * FF, wt, TC, D, FF / 4, FF}; pg8::SplitKOrder S; S.init(TC, D, 4, G, bid);
                EpiPartial E{P2};
                pg8::gemm_phase<EpiPartial, pg8::SplitKOrder>(glds, g, S, E); }
        }
        if (IN(base + 8) && G == 256 && ctx_ffn && l + 1 < DEPTH && bid >= 128) {
#pragma unroll 1
            for (int q = 0; q < 2; ++q) convert_layer(c, q ? 3 : l + 1, q ? (l == 0 ? L3_C0 : L3_C1) : slot_b_end(l + 1), q ? (l == 0 ? L3_C1 : L3_C2) : slot_c_end(l + 1), bid - 128, 128, (float*)lds); }
        SEAM(base + 8);
    }
    if (DBG(12) && IN(N_PHASES - 1)) final_norm_phase(c.X(), c.in[10], c.out, T);
#undef IN
#undef SEAM
}

extern "C" void kernel_launch(void* const* d_in, const int* in_sizes, int n_in, void* d_out, int out_size, void* d_ws, size_t ws_size, hipStream_t stream) {
    static int grid = 0;
    if (grid == 0) {
        if (n_in != 30 || out_size != T * D || ws_size < WS_END) { fprintf(stderr, "kernel_launch: unexpected shapes (n_in %d out %d ws %zu need %zu)\n", n_in, out_size, ws_size, (size_t)WS_END); grid = -1; return; }
        int dev = 0, cus = 0, per_cu = 0;
        if (hipGetDevice(&dev) != hipSuccess || hipDeviceGetAttribute(&cus, hipDeviceAttributeMultiprocessorCount, dev) != hipSuccess) { grid = -1; return; }
        if (hipFuncSetAttribute((const void*)fwd_kernel, hipFuncAttributeMaxDynamicSharedMemorySize, LDS_BYTES) != hipSuccess) { fprintf(stderr, "kernel_launch: hipFuncSetAttribute failed\n"); grid = -1; return; }
        if (hipOccupancyMaxActiveBlocksPerMultiprocessor(&per_cu, (const void*)fwd_kernel, NTHREADS, LDS_BYTES) != hipSuccess || per_cu < 1) fprintf(stderr, "kernel_launch: occupancy query reports %d\n", per_cu);
        (void)hipGetLastError();
        grid = cus;
    }
    if (grid < 0) return;
    (void)in_sizes;
    if (hipMemsetAsync((char*)d_ws + WS_CTL, 0, CTL_BYTES, stream) != hipSuccess) return;
    Args a{};
    for (int i = 0; i < 30; ++i) a.in[i] = (const float*)d_in[i];
    a.out = (float*)d_out; a.ws = (unsigned char*)d_ws;
#if MK_PER_PHASE
    for (int p = 0; p < N_PHASES; ++p) { a.ph_lo = p; a.ph_hi = p + 1; hipLaunchKernelGGL(fwd_kernel, dim3(grid), dim3(NTHREADS), LDS_BYTES, stream, a); }
#else
    a.ph_lo = 0; a.ph_hi = N_PHASES;
    hipLaunchKernelGGL(fwd_kernel, dim3(grid), dim3(NTHREADS), LDS_BYTES, stream, a);
#endif
}
#endif
```
